# Optimizing an MI355X kernel written in HIP

```python
import functools
import jax, jax.numpy as jnp
from jax import lax
import numpy as np


D_MODEL = 1024
BATCH = 8
SEQ = 2048
DEPTH = 4
DEC_BATCH = 32
DEC_SEQ = 1
PAST_LEN = 8192
PAGE_SIZE = 128

HEAD_DIM = 64
HEADS_PER_GROUP = 4
GROUPS = ((128, 1), (512, 4), (2048, 16))
N_GROUPS = len(GROUPS)
N_HEADS = HEADS_PER_GROUP * N_GROUPS
ATTN_WIDTH = N_HEADS * HEAD_DIM
CONV_WIDTH = (3 * D_MODEL) // 4
CONV_K = 31
ROT_DIM = HEAD_DIM // 4
ROPE_THETA = 500000.0
QBLK = 128
RMS_EPS = 1e-6
LN_EPS = 1e-5
IN_SIZES = (ATTN_WIDTH, ATTN_WIDTH, ATTN_WIDTH, ATTN_WIDTH,
            CONV_WIDTH, CONV_WIDTH, CONV_WIDTH, D_MODEL, D_MODEL)
IN_COLS = sum(IN_SIZES)

kernel_name = 'dilated_attn_conformer_conv_gated_hybrid_step'


def rmsnorm(x, g):
    xf = x.astype(jnp.float32)
    y = xf * lax.rsqrt(jnp.mean(xf * xf, axis=-1, keepdims=True) + RMS_EPS)
    return (y * g.astype(jnp.float32)).astype(x.dtype)


def layernorm(x, g, b):
    xf = x.astype(jnp.float32)
    mu = jnp.mean(xf, axis=-1, keepdims=True)
    xc = xf - mu
    var = jnp.mean(xc * xc, axis=-1, keepdims=True)
    y = xc * lax.rsqrt(var + LN_EPS) * g.astype(jnp.float32) + b.astype(jnp.float32)
    return y.astype(x.dtype)


def partial_rope(x, pos):
    inv = jnp.power(jnp.float32(ROPE_THETA), -jnp.arange(0, ROT_DIM, 2, dtype=jnp.float32) / ROT_DIM)
    ang = pos.astype(jnp.float32)[:, None] * inv[None, :]
    cos = jnp.cos(ang)[None, :, None, :]
    sin = jnp.sin(ang)[None, :, None, :]
    xr = x[..., :ROT_DIM].astype(jnp.float32)
    x1, x2 = xr[..., :ROT_DIM // 2], xr[..., ROT_DIM // 2:]
    rot = jnp.concatenate([x1 * cos - x2 * sin, x2 * cos + x1 * sin], axis=-1)
    return jnp.concatenate([rot.astype(x.dtype), x[..., ROT_DIM:]], axis=-1)


def group_attend(q, k_ext, v_ext, key_idx, valid):
    kg = k_ext[:, key_idx]
    vg = v_ext[:, key_idx]
    s = jnp.einsum('bqhd,bqkhd->bhqk', q, kg).astype(jnp.float32) * (HEAD_DIM ** -0.5)
    s = jnp.where(valid[None, None], s, jnp.finfo(jnp.float32).min)
    m = jnp.max(s, axis=-1, keepdims=True)
    p = jnp.exp(s - m)
    den = jnp.sum(p, axis=-1, keepdims=True)
    o = jnp.einsum('bhqk,bqkhd->bqhd', p.astype(vg.dtype), vg).astype(jnp.float32)
    o = o / jnp.transpose(den, (0, 2, 1, 3))
    lse = (m + jnp.log(den))[..., 0]
    return o, lse


def combine_groups(outs, lses, dtype):
    alpha = jax.nn.softmax(jnp.stack(lses, axis=0), axis=0)
    parts = [o * jnp.transpose(alpha[g], (0, 2, 1))[..., None] for g, o in enumerate(outs)]
    y = jnp.concatenate(parts, axis=2)
    return y.reshape(y.shape[0], y.shape[1], ATTN_WIDTH).astype(dtype)


def attn_prompt(q, k, v):
    B, S = q.shape[0], q.shape[1]
    i = jnp.arange(QBLK)
    kps, vps, states_k, states_v = [], [], [], []
    for g, (W, d) in enumerate(GROUPS):
        hs = slice(g * HEADS_PER_GROUP, (g + 1) * HEADS_PER_GROUP)
        kg, vg = k[:, :, hs], v[:, :, hs]
        kps.append(jnp.pad(kg, ((0, 0), (W, 0), (0, 0), (0, 0))))
        vps.append(jnp.pad(vg, ((0, 0), (W, 0), (0, 0), (0, 0))))
        keep = min(W, S)
        states_k.append(kg[:, S - keep:])
        states_v.append(vg[:, S - keep:])

    def block(b):
        s0 = b * QBLK
        qb = lax.dynamic_slice_in_dim(q, s0, QBLK, axis=1)
        outs, lses = [], []
        for g, (W, d) in enumerate(GROUPS):
            hs = slice(g * HEADS_PER_GROUP, (g + 1) * HEADS_PER_GROUP)
            j = jnp.arange(W // d + 1)
            kb = lax.dynamic_slice_in_dim(kps[g], s0, W + QBLK, axis=1)
            vb = lax.dynamic_slice_in_dim(vps[g], s0, W + QBLK, axis=1)
            key_idx = W + i[:, None] - d * j[None, :]
            valid = (s0 + i[:, None] - d * j[None, :]) >= 0
            o, l = group_attend(qb[:, :, hs], kb, vb, key_idx, valid)
            outs.append(o)
            lses.append(l)
        return combine_groups(outs, lses, q.dtype)

    y = lax.map(block, jnp.arange(S // QBLK))
    y = jnp.transpose(y, (1, 0, 2, 3)).reshape(B, S, ATTN_WIDTH)
    return y, (states_k, states_v)


def attn_sample(q, k, v, caches_k, caches_v):
    T = q.shape[1]
    i = jnp.arange(T)
    outs, lses, states_k, states_v = [], [], [], []
    for g, (W, d) in enumerate(GROUPS):
        hs = slice(g * HEADS_PER_GROUP, (g + 1) * HEADS_PER_GROUP)
        ck, cv = caches_k[g], caches_v[g]
        L = ck.shape[1]
        ke = jnp.concatenate([ck.astype(k.dtype), k[:, :, hs]], axis=1)
        ve = jnp.concatenate([cv.astype(v.dtype), v[:, :, hs]], axis=1)
        j = jnp.arange(W // d + 1)
        key_idx = L + i[:, None] - d * j[None, :]
        valid = key_idx >= 0
        o, l = group_attend(q[:, :, hs], ke, ve, jnp.maximum(key_idx, 0), valid)
        outs.append(o)
        lses.append(l)
        keep = min(W, L + T)
        states_k.append(ke[:, L + T - keep:])
        states_v.append(ve[:, L + T - keep:])
    return combine_groups(outs, lses, q.dtype), (states_k, states_v)


def causal_dwconv(u_ext, w):
    C = u_ext.shape[-1]
    return lax.conv_general_dilated(u_ext, w[:, None, :].astype(u_ext.dtype), window_strides=(1,),
                                    padding='VALID', dimension_numbers=('NWC', 'WIO', 'NWC'),
                                    feature_group_count=C)


def conv_prompt(u, w):
    ext = jnp.pad(u, ((0, 0), (CONV_K - 1, 0), (0, 0)))
    return causal_dwconv(ext, w), u[:, u.shape[1] - (CONV_K - 1):]


def conv_sample(u, w, buf):
    ext = jnp.concatenate([buf.astype(u.dtype), u], axis=1)
    return causal_dwconv(ext, w), ext[:, ext.shape[1] - (CONV_K - 1):]


def trunk_layer(x, pos, attn_mixer, conv_mixer, w_in, w_ao, w_co, w_o, cw, ln_g, ln_b, g_pre, g_post):
    B, S = x.shape[0], x.shape[1]
    h = rmsnorm(x, g_pre)
    z = h @ w_in
    q, k, v, ga, ca, cb, gc, ma, mc = jnp.split(z, list(np.cumsum(IN_SIZES)[:-1]), axis=-1)
    q = partial_rope(q.reshape(B, S, N_HEADS, HEAD_DIM), pos)
    k = partial_rope(k.reshape(B, S, N_HEADS, HEAD_DIM), pos)
    v = v.reshape(B, S, N_HEADS, HEAD_DIM)
    a, kv_state = attn_mixer(q, k, v)
    ya = (a * jax.nn.silu(ga)) @ w_ao
    u = ca * jax.nn.sigmoid(cb)
    cdw, conv_state = conv_mixer(u, cw)
    yc = (jax.nn.silu(layernorm(cdw, ln_g, ln_b)) * jax.nn.silu(gc)) @ w_co
    merged = jax.nn.sigmoid(ma) * ya + jax.nn.sigmoid(mc) * yc
    out = rmsnorm(merged @ w_o, g_post)
    return x + out, kv_state, conv_state


def setup_inputs(seed: int = 0) -> dict:
    key = jax.random.key(seed)
    ks = jax.random.split(key, 20)
    f32 = jnp.float32
    d = {}
    d['x_prompt'] = jax.random.normal(ks[0], (BATCH, SEQ, D_MODEL), f32)
    d['x_sample'] = jax.random.normal(ks[1], (DEC_BATCH, DEC_SEQ, D_MODEL), f32)
    for g, (W, _) in enumerate(GROUPS):
        L = min(W, PAST_LEN)
        shp = (DEPTH, DEC_BATCH, L, HEADS_PER_GROUP, HEAD_DIM)
        d['cache_k%d' % g] = jax.random.normal(ks[2 + 2 * g], shp, f32)
        d['cache_v%d' % g] = jax.random.normal(ks[3 + 2 * g], shp, f32)
    d['state_conv'] = jax.random.normal(ks[8], (DEPTH, DEC_BATCH, CONV_K - 1, CONV_WIDTH), f32)
    d['w_in'] = jax.random.normal(ks[9], (DEPTH, D_MODEL, IN_COLS), f32) * D_MODEL ** -0.5
    d['w_attn_out'] = jax.random.normal(ks[10], (DEPTH, ATTN_WIDTH, D_MODEL), f32) * ATTN_WIDTH ** -0.5
    d['w_conv_out'] = jax.random.normal(ks[11], (DEPTH, CONV_WIDTH, D_MODEL), f32) * CONV_WIDTH ** -0.5
    d['w_out'] = jax.random.normal(ks[12], (DEPTH, D_MODEL, D_MODEL), f32) * D_MODEL ** -0.5
    d['conv_w'] = jax.random.normal(ks[13], (DEPTH, CONV_K, CONV_WIDTH), f32) * CONV_K ** -0.5
    d['conv_ln_g'] = 1.0 + 0.02 * jax.random.normal(ks[14], (DEPTH, CONV_WIDTH), f32)
    d['conv_ln_b'] = 0.02 * jax.random.normal(ks[15], (DEPTH, CONV_WIDTH), f32)
    d['norm_pre'] = 1.0 + 0.02 * jax.random.normal(ks[16], (DEPTH, D_MODEL), f32)
    d['norm_post'] = 1.0 + 0.02 * jax.random.normal(ks[17], (DEPTH, D_MODEL), f32)
    return d


def reference(x_prompt, x_sample, cache_k0, cache_v0, cache_k1, cache_v1, cache_k2, cache_v2,
              state_conv, w_in, w_attn_out, w_conv_out, w_out, conv_w, conv_ln_g, conv_ln_b,
              norm_pre, norm_post):
    pos_p = jnp.arange(x_prompt.shape[1], dtype=jnp.int32)
    pos_s = PAST_LEN + jnp.arange(x_sample.shape[1], dtype=jnp.int32)
    yp, ys = x_prompt, x_sample
    pk = [[] for _ in GROUPS]
    pv = [[] for _ in GROUPS]
    sk = [[] for _ in GROUPS]
    sv = [[] for _ in GROUPS]
    pc, sc = [], []
    for l in range(DEPTH):
        params = (w_in[l], w_attn_out[l], w_conv_out[l], w_out[l], conv_w[l],
                  conv_ln_g[l], conv_ln_b[l], norm_pre[l], norm_post[l])
        yp, (kst, vst), cst = trunk_layer(yp, pos_p, attn_prompt, conv_prompt, *params)
        for g in range(N_GROUPS):
            pk[g].append(kst[g])
            pv[g].append(vst[g])
        pc.append(cst)
        s_attn = functools.partial(attn_sample,
                                   caches_k=(cache_k0[l], cache_k1[l], cache_k2[l]),
                                   caches_v=(cache_v0[l], cache_v1[l], cache_v2[l]))
        s_conv = functools.partial(conv_sample, buf=state_conv[l])
        ys, (kst, vst), cst = trunk_layer(ys, pos_s, s_attn, s_conv, *params)
        for g in range(N_GROUPS):
            sk[g].append(kst[g])
            sv[g].append(vst[g])
        sc.append(cst)
    return (yp, ys,
            jnp.stack(pk[0]), jnp.stack(pv[0]), jnp.stack(pk[1]), jnp.stack(pv[1]),
            jnp.stack(pk[2]), jnp.stack(pv[2]), jnp.stack(pc),
            jnp.stack(sk[0]), jnp.stack(sv[0]), jnp.stack(sk[1]), jnp.stack(sv[1]),
            jnp.stack(sk[2]), jnp.stack(sv[2]), jnp.stack(sc))
```

```cpp
#include <hip/hip_runtime.h>
#include <cstdio>
#include <cstdint>

#ifndef MK_N_LAUNCHES
#define MK_N_LAUNCHES 1
#endif

#define LAS __attribute__((address_space(3)))
#define GAS __attribute__((address_space(1)))
typedef unsigned short bf16_t;
typedef short bf16x8 __attribute__((ext_vector_type(8)));
typedef short s16x4 __attribute__((ext_vector_type(4)));
typedef float f32x4 __attribute__((ext_vector_type(4)));
typedef float f32x2 __attribute__((ext_vector_type(2)));
typedef float f32x16 __attribute__((ext_vector_type(16)));
typedef unsigned u32x4 __attribute__((ext_vector_type(4)));
typedef unsigned u32x2 __attribute__((ext_vector_type(2)));

constexpr int D_MODEL = 1024, BATCH = 8, SEQ = 2048, DEPTH = 4, DEC_BATCH = 32;
constexpr int MP = BATCH * SEQ;
constexpr int MR = MP + DEC_BATCH;
constexpr int MPAD = 16640;
constexpr int ZN = 7424;
constexpr int ZC_Q = 0, ZC_K = 768, ZC_V = 1536, ZC_GA = 2304, ZC_CA = 3072, ZC_CB = 3840, ZC_GC = 4608, ZC_MA = 5376, ZC_MC = 6400;
constexpr int AW = 768, CW = 768, CONV_K = 31;
__host__ __device__ __forceinline__ constexpr int zc_ca(int c) { return 3072 + 256 * (c >> 7) + (c & 127); }
constexpr float RMS_EPS = 1e-6f, LN_EPS = 1e-5f;
constexpr float LOG2E = 1.4426950408889634f, LN2 = 0.6931471805599453f;
constexpr float QSCALE = 0.125f * LOG2E;

constexpr size_t O_YP = 0;
constexpr size_t O_YS = O_YP + (size_t)MP * D_MODEL;
constexpr size_t O_PK0 = O_YS + (size_t)DEC_BATCH * D_MODEL;
constexpr size_t SZ_P0 = (size_t)DEPTH * BATCH * 128 * 256, SZ_P1 = (size_t)DEPTH * BATCH * 512 * 256, SZ_P2 = (size_t)DEPTH * BATCH * 2048 * 256;
constexpr size_t O_PV0 = O_PK0 + SZ_P0, O_PK1 = O_PV0 + SZ_P0, O_PV1 = O_PK1 + SZ_P1, O_PK2 = O_PV1 + SZ_P1, O_PV2 = O_PK2 + SZ_P2;
constexpr size_t O_PC = O_PV2 + SZ_P2;
constexpr size_t SZ_PC = (size_t)DEPTH * BATCH * 30 * 768;
constexpr size_t O_SK0 = O_PC + SZ_PC;
constexpr size_t SZ_S0 = (size_t)DEPTH * DEC_BATCH * 128 * 256, SZ_S1 = (size_t)DEPTH * DEC_BATCH * 512 * 256, SZ_S2 = (size_t)DEPTH * DEC_BATCH * 2048 * 256;
constexpr size_t O_SV0 = O_SK0 + SZ_S0, O_SK1 = O_SV0 + SZ_S0, O_SV1 = O_SK1 + SZ_S1, O_SK2 = O_SV1 + SZ_S1, O_SV2 = O_SK2 + SZ_S2;
constexpr size_t O_SC = O_SV2 + SZ_S2;
constexpr size_t SZ_SC = (size_t)DEPTH * DEC_BATCH * 30 * 768;
constexpr size_t O_END = O_SC + SZ_SC;
static_assert(O_END == 240697344ull, "output size");

constexpr size_t MiB = 1u << 20;
constexpr size_t WS_CTL = 0, CTL_ZERO_BYTES = 2 * MiB;
constexpr size_t WS_XB1 = 1 * MiB;
constexpr size_t WS_XB2 = WS_XB1 + (size_t)16384 * 4 * 8;
constexpr size_t WS_ROPE = 2 * MiB;
constexpr size_t WS_WIN = 3 * MiB;
constexpr size_t SZ_WIN1 = (size_t)ZN * 1024 * 2;
constexpr size_t WS_WAO = WS_WIN + 4 * SZ_WIN1;
constexpr size_t SZ_WAO1 = (size_t)1024 * 768 * 2;
constexpr size_t WS_WCO = WS_WAO + 4 * SZ_WAO1;
constexpr size_t WS_WO = WS_WCO + 4 * SZ_WAO1;
constexpr size_t SZ_WO1 = (size_t)1024 * 1024 * 2;
constexpr size_t WS_H = WS_WO + 4 * SZ_WO1;
constexpr size_t WS_Z = WS_H + (size_t)MPAD * 1024 * 2;
constexpr size_t WS_A2 = WS_Z + (size_t)MPAD * ZN * 2;
constexpr size_t WS_C2 = WS_A2 + (size_t)MPAD * 768 * 2;
constexpr size_t WS_MG = WS_C2 + (size_t)MPAD * 768 * 2;
constexpr size_t WS_R = WS_MG + (size_t)MPAD * 1024 * 2;
constexpr size_t WS_LSE = WS_R + (size_t)MPAD * 1024 * 4;
constexpr size_t WS_CWT = WS_LSE + (size_t)MPAD * 16 * 4;
constexpr size_t WS_RS = WS_CWT + (size_t)4 * 768 * 32 * 4;
constexpr size_t WS_END = WS_RS + (size_t)MP * 4;

constexpr int CW_BAR = 4096;
constexpr int CW_SVC = 8192;
constexpr int CW_RANK = 9216;
constexpr int CW_XL = 9728;
constexpr int CW_XC = 19456, CW_XP = 19968;
constexpr int CW_XA = 18432;
constexpr int CW_PAN1 = 10240, CW_PAN2 = 14336;
constexpr int NSVC = 24, NG1 = 232;

constexpr int RING_BYTES = 131072;
constexpr int LDSCTL_OFF = 150528;
constexpr int MISC_OFF = LDSCTL_OFF + 320;
constexpr int LDS_BYTES = LDSCTL_OFF + 1024;
constexpr int NWAVES = 8;

#define RLX_AGENT __ATOMIC_RELAXED, __HIP_MEMORY_SCOPE_AGENT
#define LDS_WAIT() asm volatile("s_waitcnt lgkmcnt(0)" ::: "memory")
#define VM_WAIT() asm volatile("s_waitcnt vmcnt(0)" ::: "memory")

__device__ __forceinline__ unsigned cvt_pk_bf16(float lo, float hi) { unsigned r; asm volatile("v_cvt_pk_bf16_f32 %0, %1, %2" : "=v"(r) : "v"(lo), "v"(hi)); return r; }
__device__ __forceinline__ void st_wt16(bf16_t* p, bf16_t v) { __hip_atomic_store(p, v, __ATOMIC_RELAXED, __HIP_MEMORY_SCOPE_AGENT); }
__device__ __forceinline__ void st_wt32(float* p, float v) { __hip_atomic_store((unsigned*)p, __float_as_uint(v), __ATOMIC_RELAXED, __HIP_MEMORY_SCOPE_AGENT); }
__device__ __forceinline__ void st_wt64(void* p, u32x2 v) { __hip_atomic_store((unsigned long long*)p, ((unsigned long long)v.y << 32) | v.x, __ATOMIC_RELAXED, __HIP_MEMORY_SCOPE_AGENT); }
__device__ __forceinline__ void st16f_wt(void* p, f32x4 v) { asm volatile("global_store_dwordx4 %0, %1, off sc1\n\ts_nop 1" :: "v"((GAS void*)p), "v"(v) : "memory"); }
__device__ __forceinline__ float bf_lo(unsigned u) { return __uint_as_float(u << 16); }
__device__ __forceinline__ float bf_hi(unsigned u) { return __uint_as_float(u & 0xffff0000u); }
__device__ __forceinline__ float bf1(bf16_t u) { return __uint_as_float(((unsigned)u) << 16); }
__device__ __forceinline__ float sigmoidf_(float x) { return __builtin_amdgcn_rcpf(1.0f + __expf(-x)); }
__device__ __forceinline__ float siluf_(float x) { return x * __builtin_amdgcn_rcpf(1.0f + __expf(-x)); }
__device__ __forceinline__ float wave_sum(float v) {
#pragma unroll
    for (int o = 1; o < 64; o <<= 1) v += __shfl_xor(v, o);
    return v;
}
__device__ __forceinline__ float wave_max(float v) {
#pragma unroll
    for (int o = 1; o < 64; o <<= 1) v = fmaxf(v, __shfl_xor(v, o));
    return v;
}

namespace pg8 {
constexpr int BM = 256, BK = 64, HALF = 128, HTB = HALF * BK * 2, STAGE_BYTES = 8 * HTB, NXCD = 8, WGM = 8;
__host__ __device__ __forceinline__ int lds_byte(int r, int c) { const int st = (r >> 4) * 2 + (c >> 5), rr = r & 15, cc = c & 31, ob = rr * 64 + cc * 2; return st * 1024 + (ob ^ (((ob >> 9) & 1) << 5)); }
__host__ __device__ __forceinline__ void stage_rc(int b, int& R, int& C) { const int st = b / 1024, sb = b % 1024, swz = sb ^ (((sb >> 9) & 1) << 5); R = (st >> 1) * 16 + swz / 64; C = (st & 1) * 32 + (swz % 64) / 2; }
__host__ __device__ __forceinline__ int perm32(int rho) { const int n = rho >> 4, i = rho & 15; return 8 * (i >> 2) + 4 * n + (i & 3); }

struct Unit { int pm, pn, which; };

struct Sched {
    int nM, nN, nwg, G, c, NW, wgm = WGM; bool rev = false;
    const char* A[2]; const char* B[2]; size_t tstep;
    __device__ void init(int M, int N, int K, int G_, int c_, int NW_, const void* A0, const void* B0, const void* A1, const void* B1) {
        nM = M / BM; nN = N / BM; nwg = nM * nN; G = G_; c = c_; NW = NW_; A[0] = (const char*)A0; A[1] = (const char*)A1; B[0] = (const char*)B0; B[1] = (const char*)B1; tstep = (size_t)BM * K * 2; }
    __device__ bool next(int i, Unit& u) const {
        const int it = (NW == 2) ? (i >> 1) : i;
        const long L = (long)it * G + c; if (L >= nwg) return false;
        int wgid = (int)L; { const int q = nwg / NXCD, r = nwg % NXCD, xcd = wgid % NXCD, off = wgid / NXCD; wgid = (xcd < r ? xcd * (q + 1) : r * (q + 1) + (xcd - r) * q) + off; }
        if (rev) {
            const int x2 = wgid / 232, w = wgid % 232; int g, tau;
            if (w < 174) { g = w >= 87; tau = w - 87 * g; } else { g = w >= 203; tau = w - 87 - 29 * g; }
            const int j = tau >> 2;
            u.pm = x2 * 8 + g * 4 + (tau & 3); u.pn = ((unsigned)(j - 8) < 12u) ? j + 1 : 28 - j; u.which = 0; return true;
        }
        const int nig = wgm * nN, gid = wgid / nig, fm = gid * wgm, gsz = (nM - fm) < wgm ? (nM - fm) : wgm;
        u.pm = fm + ((wgid % nig) % gsz); u.pn = (wgid % nig) / gsz; u.which = (NW == 2) ? (i & 1) : 0; return true;
    }
    __device__ __forceinline__ const char* abase(const Unit& u) const { return (u.which ? A[1] : A[0]) + (size_t)u.pm * tstep; }
    __device__ __forceinline__ const char* bbase(const Unit& u) const { return (u.which ? B[1] : B[0]) + (size_t)u.pn * tstep; }
};

template <class Epi, bool ALIGN_EPI = true>
__device__ __forceinline__ void gemm_phase(LAS unsigned char* lds, const int K, const Sched& S, const Epi& E, const int tid) {
    const int wid = __builtin_amdgcn_readfirstlane(tid >> 6), lane = tid & 63, wr = wid >> 2, wc = wid & 3, fr = lane & 15, fq = lane >> 4;
    const int nt = K / BK;
    unsigned voffA[2], voffB[2];
#pragma unroll
    for (int i = 0; i < 2; ++i) { int R, C; stage_rc(tid * 16 + i * 8192, R, C); const int Rb = Epi::PERM ? ((R & ~31) + perm32(R & 31)) : R;
        voffA[i] = (unsigned)(R * K + C) * 2u; voffB[i] = (unsigned)(Rb * K + C) * 2u; }
    const size_t kstep = (size_t)(BK * 2);
    const size_t hstep = (size_t)HALF * K * 2;
    const unsigned ldsw = (unsigned)wid * 1024u;
    const int aoff = lds_byte(wr * 64 + fr, fq * 8), boff = lds_byte(wc * 32 + fr, fq * 8);
#define PG8_SA(b, h) (((b) * 2 + (h)) * HTB)
#define PG8_SB(b, h) ((4 + (b) * 2 + (h)) * HTB)
#define PG8_STAGE(bufoff, gbase, voff) do { _Pragma("unroll") for (int _i = 0; _i < 2; ++_i) \
        __builtin_amdgcn_global_load_lds((const unsigned*)((const char*)(gbase) + (voff)[_i]), (LAS unsigned*)(lds + (bufoff) + ldsw + _i * 8192), 16, 0, 0); } while (0)
#define PG8_STAGEB(bufoff, gbase, voff) do { _Pragma("unroll") for (int _i = 0; _i < 2; ++_i) \
        __builtin_amdgcn_global_load_lds((const unsigned*)((const char*)(gbase) + (voff)[_i]), (LAS unsigned*)(lds + (bufoff) + ldsw + _i * 8192), 16, 0, Epi::B_NT ? 2 : 0); } while (0)
#define PG8_LDA(dst, b, h) do { _Pragma("unroll") for (int m = 0; m < 4; ++m) _Pragma("unroll") for (int k = 0; k < 2; ++k) dst[m][k] = *(const LAS bf16x8*)(lds + PG8_SA(b, h) + aoff + m * 2048 + k * 1024); } while (0)
#define PG8_LDB(dst, b, h) do { _Pragma("unroll") for (int n = 0; n < 2; ++n) _Pragma("unroll") for (int k = 0; k < 2; ++k) dst[n][k] = *(const LAS bf16x8*)(lds + PG8_SB(b, h) + boff + n * 2048 + k * 1024); } while (0)
#define PG8_MMA(ai, bj, At, Bt) do { __builtin_amdgcn_s_setprio(1); _Pragma("unroll") for (int m = 0; m < 4; ++m) _Pragma("unroll") for (int n = 0; n < 2; ++n) _Pragma("unroll") for (int k = 0; k < 2; ++k) \
        acc[ai][bj][m][n] = __builtin_amdgcn_mfma_f32_16x16x32_bf16(Bt[n][k], At[m][k], acc[ai][bj][m][n], 0, 0, 0); __builtin_amdgcn_s_setprio(0); } while (0)
#define PG8_WAIT_V(n) asm volatile("s_waitcnt vmcnt(" #n ")" ::: "memory")
#define PG8_WAIT_L(n) asm volatile("s_waitcnt lgkmcnt(" #n ")" ::: "memory")
#define PG8_BAR __builtin_amdgcn_s_barrier()
#define PG8_SCHED __builtin_amdgcn_sched_barrier(0)
    Unit cur, nxt; int ui = 0;
    if (!S.next(0, cur)) return;
    f32x4 acc[2][2][4][2];
#pragma unroll
    for (int a = 0; a < 2; ++a)
#pragma unroll
        for (int b = 0; b < 2; ++b)
#pragma unroll
            for (int m = 0; m < 4; ++m)
#pragma unroll
                for (int n = 0; n < 2; ++n) acc[a][b][m][n] = (f32x4){0.f, 0.f, 0.f, 0.f};
    bf16x8 At[4][2], B0[2][2], B1[2][2];
    const char* cA = S.abase(cur); const char* cB = S.bbase(cur);
    PG8_STAGEB(PG8_SB(0, 0), cB, voffB); PG8_STAGEB(PG8_SB(0, 1), cB + hstep, voffB);
    if constexpr (Epi::WAIT_A) E.pre_a(cur, tid);
    PG8_STAGE(PG8_SA(0, 0), cA, voffA); PG8_STAGE(PG8_SA(0, 1), cA + hstep, voffA);
    if (wr == 1) PG8_BAR;
    PG8_WAIT_V(2); PG8_BAR;
    PG8_STAGEB(PG8_SB(1, 0), cB + kstep, voffB); PG8_STAGE(PG8_SA(1, 0), cA + kstep, voffA); PG8_STAGEB(PG8_SB(1, 1), cB + hstep + kstep, voffB);
    PG8_WAIT_V(6); PG8_BAR;
    for (;;) {
        const bool has_next = S.next(ui + 1, nxt);
        const char* nA = has_next ? S.abase(nxt) : cA; const char* nB = has_next ? S.bbase(nxt) : cB;
        for (int t = 0; t < nt; t += 2) {
            if constexpr (Epi::WAIT_MID) { if (t == nt - 4 && cur.which == 0) E.mid_wait(tid); }
            const bool last = (t == nt - 2);
            const char* a1 = cA + (size_t)(t + 1) * kstep;
            const char* a2 = last ? nA : cA + (size_t)(t + 2) * kstep; const char* b2 = last ? nB : cB + (size_t)(t + 2) * kstep;
            const char* a3 = a2 + kstep; const char* b3 = b2 + kstep;
            PG8_LDB(B0, 0, 0); PG8_LDB(B1, 0, 1); PG8_SCHED; PG8_LDA(At, 0, 0); PG8_STAGE(PG8_SA(1, 1), a1 + hstep, voffA);
            PG8_WAIT_V(8); PG8_WAIT_L(0); PG8_BAR; PG8_MMA(0, 0, At, B0); PG8_MMA(0, 1, At, B1); PG8_BAR; PG8_SCHED;
            PG8_LDA(At, 0, 1); PG8_STAGEB(PG8_SB(0, 0), b2, voffB); PG8_STAGEB(PG8_SB(0, 1), b2 + hstep, voffB); PG8_STAGE(PG8_SA(0, 0), a2, voffA);
            PG8_WAIT_V(8); PG8_WAIT_L(0); PG8_BAR; PG8_MMA(1, 0, At, B0); PG8_MMA(1, 1, At, B1); PG8_BAR; PG8_SCHED;
            PG8_LDB(B0, 1, 0); PG8_LDB(B1, 1, 1); PG8_SCHED; PG8_LDA(At, 1, 0); PG8_STAGE(PG8_SA(0, 1), a2 + hstep, voffA);
            PG8_WAIT_V(8); PG8_WAIT_L(0); PG8_BAR; PG8_MMA(0, 0, At, B0); PG8_MMA(0, 1, At, B1); PG8_BAR; PG8_SCHED;
            PG8_LDA(At, 1, 1); PG8_STAGEB(PG8_SB(1, 0), b3, voffB); PG8_STAGEB(PG8_SB(1, 1), b3 + hstep, voffB); PG8_STAGE(PG8_SA(1, 0), a3, voffA);
            PG8_WAIT_V(8); PG8_WAIT_L(0); PG8_BAR; PG8_MMA(1, 0, At, B0); PG8_MMA(1, 1, At, B1); PG8_BAR; PG8_SCHED;
        }
        if constexpr (ALIGN_EPI) { if (wr == 0) PG8_BAR; }
        if constexpr (!Epi::AFTER_DRAIN) E(acc, cur, wr, wc, fr, fq, ui);
        if (!has_next) break;
        if (!Epi::keep_acc(cur)) {
#pragma unroll
        for (int a = 0; a < 2; ++a)
#pragma unroll
            for (int b = 0; b < 2; ++b)
#pragma unroll
                for (int m = 0; m < 4; ++m)
#pragma unroll
                    for (int n = 0; n < 2; ++n) acc[a][b][m][n] = (f32x4){0.f, 0.f, 0.f, 0.f};
        }
        cur = nxt; cA = nA; cB = nB; ++ui;
        if constexpr (ALIGN_EPI) { if (wr == 1) PG8_BAR; }
    }
    PG8_WAIT_V(0);
    if constexpr (!ALIGN_EPI) { if (wr == 0) PG8_BAR; }
    PG8_BAR;
    if constexpr (Epi::AFTER_DRAIN) E.fused(acc, cur, wr, wc, fr, fq, lds, tid);
#undef PG8_SA
#undef PG8_SB
#undef PG8_STAGE
#undef PG8_STAGEB
#undef PG8_LDA
#undef PG8_LDB
#undef PG8_MMA
#undef PG8_WAIT_V
#undef PG8_WAIT_L
#undef PG8_BAR
#undef PG8_SCHED
}
}

#define XB_TMO      128
#define XB_XCNT(j)  (256  + 64 * (j))
#define XB_XSUB(j)  (1280 + 64 * (j))
#define XB_XGEN(j)  (2304 + 64 * (j))
#define XB_TOP      3328
#define XB_TOPGEN   3392
#define XCD_BAR_WORDS 3456
#define XB_SPIN_CAP (1u << 20)
__device__ __forceinline__ unsigned xb_ld(unsigned* p)              { return __hip_atomic_load(p, __ATOMIC_RELAXED, __HIP_MEMORY_SCOPE_AGENT); }
__device__ __forceinline__ unsigned xb_add(unsigned* p, unsigned v) { return __hip_atomic_fetch_add(p, v, __ATOMIC_RELAXED, __HIP_MEMORY_SCOPE_AGENT); }
__device__ __forceinline__ unsigned xb_xcc_id() { return (unsigned)__builtin_amdgcn_s_getreg((3 << 11) | 20) & 0xFu; }
#define XB_SPIN(cond, bar) do { unsigned _sp = 0; while (cond) { __builtin_amdgcn_s_sleep(1); \
    if ((++_sp & 255u) == 0u) { if (xb_ld(&(bar)[XB_TMO])) break; if (_sp > XB_SPIN_CAP) { atomicAdd(&(bar)[XB_TMO], 1u); break; } } } } while (0)
struct XcdBarrier { unsigned* bar; unsigned x; volatile LAS unsigned* st; };
__device__ __forceinline__ XcdBarrier xcd_barrier_post(unsigned* bar, volatile LAS unsigned* st) {
    XcdBarrier b; b.bar = bar; b.x = xb_xcc_id(); b.st = st;
    if (threadIdx.x == 0) (void)xb_add(&bar[XB_XCNT(b.x)], 1u);
    return b;
}
__device__ __forceinline__ void xcd_barrier_complete(unsigned* bar, unsigned x, unsigned& nloc, unsigned& nx) {
    const unsigned G = gridDim.x * gridDim.y * gridDim.z;
    unsigned sum, cnt, mine, sp = 0u;
    for (;;) {
        sum = 0u; cnt = 0u; mine = 0u;
#pragma unroll
        for (unsigned j = 0; j < 16; ++j) { const unsigned c = xb_ld(&bar[XB_XCNT(j)]); sum += c; cnt += (c > 0u) ? 1u : 0u; mine = (j == x) ? c : mine; }
        if (sum == G) break;
        __builtin_amdgcn_s_sleep(1);
        if ((++sp & 255u) == 0u) { if (xb_ld(&bar[XB_TMO])) break; if (sp > XB_SPIN_CAP) { atomicAdd(&bar[XB_TMO], 1u); break; } }
    }
    nloc = mine > 0u ? mine : 1u; nx = cnt > 0u ? cnt : 1u;
}
__device__ __forceinline__ void xcd_barrier(const XcdBarrier& b) {
    asm volatile("s_waitcnt vmcnt(0)" ::: "memory");
    __syncthreads();
    if (threadIdx.x == 0) {
        unsigned* bar = b.bar;
        __builtin_amdgcn_s_waitcnt(0);
        unsigned nloc = b.st[0], nx = b.st[1];
        if (nloc == 0u) { xcd_barrier_complete(bar, b.x, nloc, nx); b.st[0] = nloc; b.st[1] = nx; }
        const unsigned old = xb_add(&bar[XB_XSUB(b.x)], 1u);
        const unsigned gen = old / nloc;
        if (old + 1u == (gen + 1u) * nloc) {
            __builtin_amdgcn_fence(__ATOMIC_RELEASE, "agent");
            asm volatile("s_waitcnt vmcnt(0)" ::: "memory");
            const unsigned og = xb_add(&bar[XB_TOP], 1u);
            const unsigned tg = og / nx;
            if (og + 1u == (tg + 1u) * nx) xb_add(&bar[XB_TOPGEN], 1u);
            else XB_SPIN(xb_ld(&bar[XB_TOPGEN]) == tg, bar);
            __builtin_amdgcn_fence(__ATOMIC_ACQUIRE, "agent");
            xb_add(&bar[XB_XGEN(b.x)], 1u);
            asm volatile("s_waitcnt vmcnt(0)" ::: "memory");
        } else {
            XB_SPIN(xb_ld(&bar[XB_XGEN(b.x)]) == gen, bar);
            __builtin_amdgcn_fence(__ATOMIC_ACQUIRE, "agent");
            asm volatile("s_waitcnt vmcnt(0)" ::: "memory");
        }
    }
    __syncthreads();
}

__device__ __forceinline__ void xl_barrier(unsigned* ctr, unsigned target) {
    asm volatile("s_waitcnt vmcnt(0)" ::: "memory");
    __syncthreads();
    if (threadIdx.x == 0) {
        xb_add(ctr, 1u);
        unsigned sp = 0; while (xb_ld(ctr) < target) { __builtin_amdgcn_s_sleep(1); if (++sp > (1u << 22)) break; }
        __builtin_amdgcn_fence(__ATOMIC_ACQUIRE, "agent");
        asm volatile("s_waitcnt vmcnt(0)" ::: "memory");
    }
    __syncthreads();
}

struct Args { const float* in[18]; float* out; unsigned char* ws; int ph_lo, ph_hi, li, pad; };

struct Ctx {
    LAS unsigned char* lds;
    int tid, lane, wave, G, vcu, xcc, rank, vb;
    const float* const* in;
    float* out; unsigned char* ws;
};

constexpr int NPIECES = 43008;
struct Piece { const f32x4* s4; f32x4* d4; size_t n4, base; int W; };
__device__ __forceinline__ Piece piece_of(const float* const* in, float* out, int p, int lane) {
    const size_t v = (size_t)p * 1024; int t; size_t off;
    if (v < 1048576u) { t = 0; off = 0; } else if (v < 2097152u) { t = 1; off = 1048576u; } else if (v < 6291456u) { t = 2; off = 2097152u; } else if (v < 10485760u) { t = 3; off = 6291456u; }
    else if (v < 27262976u) { t = 4; off = 10485760u; } else { t = 5; off = 27262976u; }
    Piece P; P.W = 128 << (2 * (t >> 1)); P.n4 = (size_t)DEPTH * DEC_BATCH * P.W * 64;
    const size_t doff = t == 0 ? O_SK0 : t == 1 ? O_SV0 : t == 2 ? O_SK1 : t == 3 ? O_SV1 : t == 4 ? O_SK2 : O_SV2;
    P.s4 = (const f32x4*)in[2 + t]; P.d4 = (f32x4*)(out + doff); P.base = v - off + lane; return P;
}
#define PC_LOAD(R, P, U0, U1) _Pragma("unroll") for (int u_ = (U0); u_ < (U1); ++u_) { const size_t i_ = (P).base + 64 * u_; R[u_] = __builtin_nontemporal_load(&(P).s4[i_ + 64 < (P).n4 ? i_ + 64 : i_]); } __builtin_amdgcn_sched_barrier(0);
#define PC_STORE(R, P, U0, U1) _Pragma("unroll") for (int u_ = (U0); u_ < (U1); ++u_) { const size_t i_ = (P).base + 64 * u_; const int within_ = (int)((i_ >> 6) & (size_t)((P).W - 1)); if (within_ < (P).W - 1) __builtin_nontemporal_store(R[u_], &(P).d4[i_]); }

struct Epi1 {
    static constexpr bool PERM = true, AFTER_DRAIN = false, B_NT = false, WAIT_A = false, WAIT_MID = false;
    static __device__ __forceinline__ bool keep_acc(const pg8::Unit&) { return false; }
    bf16_t* Z; const float* rope; float* out; int layer; const float* const* in; int cslot, cwg;
    __device__ __forceinline__ void operator()(f32x4 (&acc)[2][2][4][2], const pg8::Unit& u, int wr, int wc, int fr, int fq, int ui) const {
        const int ck = ui;
        const int pid = (ck < 6) ? ((cslot + ck) * NG1 + cwg) * 8 + (wr * 4 + wc) : NPIECES;
        const bool havep = pid < NPIECES;
        Piece CP = piece_of(in, out, havep ? pid : 0, fq * 16 + fr); f32x4 cpr[16];
        if (havep) { PC_LOAD(cpr, CP, 0, 8) }
        __builtin_amdgcn_sched_barrier(0);
        const int pn = u.pn;
        const int row0 = u.pm * 256 + wr * 64 + fr;
        const int colw = wc * 32 + 8 * fq;
        const bool is_rope = (pn < 6) && ((wc & 1) == 0);
        const float qs = (pn < 3) ? QSCALE : 1.0f;
        const bool is_kv = (pn >= 3) && (pn < 9);
        const bool is_glu = (pn >= 12) && (pn < 18);
        const int g = is_kv ? (pn - 3) % 3 : 0; const bool isv = pn >= 6;
        const int Wg = 128 << (2 * g);
        size_t pbase, sbase;
        { const size_t pk[3] = {O_PK0, O_PK1, O_PK2}, pv[3] = {O_PV0, O_PV1, O_PV2}, sk[3] = {O_SK0, O_SK1, O_SK2}, sv[3] = {O_SV0, O_SV1, O_SV2};
          pbase = isv ? pv[g] : pk[g]; sbase = isv ? sv[g] : sk[g]; }
        const float sgn = (fq == 0) ? -1.0f : 1.0f;
#pragma unroll
        for (int ai = 0; ai < 2; ++ai)
#pragma unroll
            for (int m = 0; m < 4; ++m) {
                if (ai == 1 && m == 0) { __builtin_amdgcn_sched_barrier(0); if (havep) { PC_LOAD(cpr, CP, 8, 16) } }
                const int r = row0 + ai * 128 + m * 16;
                f32x4 cs0, cs1, sn0, sn1;
                if (is_rope) {
                    const int pidx = (r < MP) ? (r & 2047) : 2048;
                    const f32x4* rp = (const f32x4*)(rope + (size_t)pidx * 16);
                    cs0 = rp[0]; cs1 = rp[1]; sn0 = rp[2]; sn1 = rp[3];
                }
                float* st_dst = nullptr;
                if (is_kv) {
                    if (r < MP) { const int b = r >> 11, s = r & 2047; if (s >= 2048 - Wg) st_dst = out + pbase + ((size_t)((layer * 8 + b) * Wg + (s - (2048 - Wg)))) * 256 + colw; }
                    else if (r < MR) { const int b = r - MP; st_dst = out + sbase + ((size_t)((layer * 32 + b) * Wg + (Wg - 1))) * 256 + colw; }
                }
                bf16_t* zrow = Z + (size_t)r * ZN + pn * 256 + colw;
                if (is_glu) {
                    const f32x4 a0 = acc[ai][0][m][0], a1 = acc[ai][0][m][1], b0 = acc[ai][1][m][0], b1 = acc[ai][1][m][1];
                    f32x4 u0, u1;
#pragma unroll
                    for (int e = 0; e < 4; ++e) { u0[e] = a0[e] * sigmoidf_(b0[e]); u1[e] = a1[e] * sigmoidf_(b1[e]); }
                    u32x4 w; w.x = cvt_pk_bf16(u0[0], u0[1]); w.y = cvt_pk_bf16(u0[2], u0[3]); w.z = cvt_pk_bf16(u1[0], u1[1]); w.w = cvt_pk_bf16(u1[2], u1[3]);
                    *(u32x4*)zrow = w;
                    const int s = r & 2047;
                    if (s >= 2018) { float* pc = out + O_PC + ((size_t)((layer * 8 + (r >> 11)) * 30 + (s - 2018))) * 768 + (pn - 12) * 128 + colw; __builtin_nontemporal_store(u0, (f32x4*)pc); __builtin_nontemporal_store(u1, (f32x4*)(pc + 4)); }
                    continue;
                }
#pragma unroll
                for (int bj = 0; bj < 2; ++bj) {
                    f32x4 v0 = acc[ai][bj][m][0], v1 = acc[ai][bj][m][1];
                    if (is_rope) {
                        f32x4 p0, p1;
#pragma unroll
                        for (int e = 0; e < 4; ++e) { p0[e] = __shfl_xor(v0[e], 16); p1[e] = __shfl_xor(v1[e], 16); }
                        if (fq < 2) { v0 = v0 * cs0 + (p0 * sn0) * sgn; v1 = v1 * cs1 + (p1 * sn1) * sgn; }
                    }
                    v0 = v0 * qs; v1 = v1 * qs;
                    if (st_dst) { __builtin_nontemporal_store(v0, (f32x4*)(st_dst + bj * 128)); __builtin_nontemporal_store(v1, (f32x4*)(st_dst + bj * 128 + 4)); }
                    u32x4 w; w.x = cvt_pk_bf16(v0[0], v0[1]); w.y = cvt_pk_bf16(v0[2], v0[3]); w.z = cvt_pk_bf16(v1[0], v1[1]); w.w = cvt_pk_bf16(v1[2], v1[3]);
                    *(u32x4*)(zrow + bj * 128) = w;
                }
            }
        __builtin_amdgcn_sched_barrier(0);
        if (havep) { PC_STORE(cpr, CP, 0, 16) }
    }
};

struct Epi2 {
    static constexpr bool PERM = true, AFTER_DRAIN = false, B_NT = false, WAIT_A = true, WAIT_MID = true;
    static __device__ __forceinline__ bool keep_acc(const pg8::Unit& u) { return u.which == 0; }
    const bf16_t* Z; bf16_t* MG; unsigned* xc; unsigned* xp; unsigned xtarget;
    __device__ __forceinline__ void wait_ctr(const unsigned* ctr, int tid) const {
        if (tid == 0) { unsigned sp = 0; while (xb_ld((unsigned*)ctr) < xtarget) { __builtin_amdgcn_s_sleep(1); if (++sp > (1u << 22)) break; }
            __builtin_amdgcn_fence(__ATOMIC_ACQUIRE, "agent"); }
        __builtin_amdgcn_s_barrier();
    }
    __device__ __forceinline__ void pre_a(const pg8::Unit&, int tid) const { wait_ctr(xc, tid); }
    __device__ __forceinline__ void mid_wait(int tid) const { wait_ctr(xp, tid); }
    __device__ __forceinline__ void operator()(f32x4 (&acc)[2][2][4][2], const pg8::Unit& u, int wr, int wc, int fr, int fq, int ui) const {
        const int row0 = u.pm * 256 + wr * 64 + fr, col0 = u.pn * 256 + wc * 32 + 8 * fq;
#pragma unroll
        for (int ai = 0; ai < 2; ++ai) {
            u32x4 gc_[4][2], ga_[4][2];
#pragma unroll
            for (int m = 0; m < 4; ++m)
#pragma unroll
                for (int bj = 0; bj < 2; ++bj) { const int r = row0 + ai * 128 + m * 16;
                    gc_[m][bj] = (u.which == 0) ? *(const u32x4*)(Z + (size_t)r * ZN + ZC_MA + col0 + bj * 128) : __builtin_nontemporal_load((const u32x4*)(Z + (size_t)r * ZN + ZC_MA + col0 + bj * 128));
                    ga_[m][bj] = (u.which == 0) ? __builtin_nontemporal_load((const u32x4*)(Z + (size_t)r * ZN + ZC_MC + col0 + bj * 128)) : (u32x4){0u, 0u, 0u, 0u}; }
            __builtin_amdgcn_sched_barrier(0);
#pragma unroll
            for (int m = 0; m < 4; ++m)
#pragma unroll
                for (int bj = 0; bj < 2; ++bj) { const int r = row0 + ai * 128 + m * 16;
                    const u32x4 c = gc_[m][bj], a = ga_[m][bj];
                    f32x4 v0 = acc[ai][bj][m][0], v1 = acc[ai][bj][m][1];
                    if (u.which == 0) {
                        v0[0] *= sigmoidf_(bf_lo(a.x)) * (1.0f + __expf(-bf_lo(c.x))); v0[1] *= sigmoidf_(bf_hi(a.x)) * (1.0f + __expf(-bf_hi(c.x))); v0[2] *= sigmoidf_(bf_lo(a.y)) * (1.0f + __expf(-bf_lo(c.y))); v0[3] *= sigmoidf_(bf_hi(a.y)) * (1.0f + __expf(-bf_hi(c.y)));
                        v1[0] *= sigmoidf_(bf_lo(a.z)) * (1.0f + __expf(-bf_lo(c.z))); v1[1] *= sigmoidf_(bf_hi(a.z)) * (1.0f + __expf(-bf_hi(c.z))); v1[2] *= sigmoidf_(bf_lo(a.w)) * (1.0f + __expf(-bf_lo(c.w))); v1[3] *= sigmoidf_(bf_hi(a.w)) * (1.0f + __expf(-bf_hi(c.w)));
                        acc[ai][bj][m][0] = v0; acc[ai][bj][m][1] = v1;
                    } else {
                        v0[0] *= sigmoidf_(bf_lo(c.x)); v0[1] *= sigmoidf_(bf_hi(c.x)); v0[2] *= sigmoidf_(bf_lo(c.y)); v0[3] *= sigmoidf_(bf_hi(c.y));
                        v1[0] *= sigmoidf_(bf_lo(c.z)); v1[1] *= sigmoidf_(bf_hi(c.z)); v1[2] *= sigmoidf_(bf_lo(c.w)); v1[3] *= sigmoidf_(bf_hi(c.w));
                        u32x4 w; w.x = cvt_pk_bf16(v0[0], v0[1]); w.y = cvt_pk_bf16(v0[2], v0[3]); w.z = cvt_pk_bf16(v1[0], v1[1]); w.w = cvt_pk_bf16(v1[2], v1[3]);
                        *(u32x4*)(MG + (size_t)r * 1024 + col0 + bj * 128) = w;
                    } }
            __builtin_amdgcn_sched_barrier(0);
        }
    }
};

template <bool FIRST>
struct Epi3F {
    static constexpr bool PERM = true, AFTER_DRAIN = true, B_NT = false, WAIT_A = true, WAIT_MID = false;
    static __device__ __forceinline__ bool keep_acc(const pg8::Unit&) { return false; }
    __device__ __forceinline__ void pre_a(const pg8::Unit& u, int tid) const {
        if (tid == 0) { unsigned sp = 0; while (xb_ld(cnt1 + 64 * u.pm) < target) { __builtin_amdgcn_s_sleep(1); if (++sp > (1u << 22)) break; }
            __builtin_amdgcn_fence(__ATOMIC_ACQUIRE, "agent"); }
        __builtin_amdgcn_s_barrier();
    }
    const float* xsrc; float* y; bf16_t* H; const float* gpost; const float* gpre; float* xb1; float* xb2; unsigned* cnt1; unsigned* cnt2; unsigned target; int last; const float* gprev; float* RS;
    static constexpr bool first = FIRST;
    __device__ __forceinline__ void row_rs(const f32x4 (&v)[2][2][4][2], const pg8::Unit& u, int wr, int wc, int fr, int fq, LAS unsigned char* lds, int tid, float* xb, unsigned* cnt) const {
        LAS float* P = (LAS float*)lds; LAS float* S = P + 1024;
#pragma unroll
        for (int ai = 0; ai < 2; ++ai)
#pragma unroll
            for (int m = 0; m < 4; ++m) { float s = 0.f;
#pragma unroll
                for (int bj = 0; bj < 2; ++bj)
#pragma unroll
                    for (int n = 0; n < 2; ++n) { const f32x4 t = v[ai][bj][m][n]; s += (t[0] * t[0] + t[1] * t[1]) + (t[2] * t[2] + t[3] * t[3]); }
                s += __shfl_xor(s, 16); s += __shfl_xor(s, 32);
                if (fq == 0) P[(ai * 128 + wr * 64 + m * 16 + fr) * 4 + wc] = s; }
        __syncthreads();
        if (tid < 256) { const float t = (P[tid * 4] + P[tid * 4 + 1]) + (P[tid * 4 + 2] + P[tid * 4 + 3]);
            unsigned long long* q = (unsigned long long*)xb + ((size_t)u.pm * 256 + tid) * 4;
            __hip_atomic_store(q + u.pn, ((unsigned long long)target << 32) | __float_as_uint(t), RLX_AGENT);
            float tot = 0.f;
#pragma unroll
            for (int j = 0; j < 4; ++j) { unsigned long long w = __hip_atomic_load(q + j, RLX_AGENT); unsigned sp = 0;
                while ((unsigned)(w >> 32) != target) { __builtin_amdgcn_s_sleep(1); w = __hip_atomic_load(q + j, RLX_AGENT); if (++sp > (1u << 22)) break; }
                tot += __uint_as_float((unsigned)w); }
            S[tid] = 1.0f / sqrtf(tot * (1.f / 1024.f) + RMS_EPS); }
        __syncthreads();
    }
    __device__ __forceinline__ void fused(f32x4 (&acc)[2][2][4][2], const pg8::Unit& u, int wr, int wc, int fr, int fq, LAS unsigned char* lds, int tid) const {
        const LAS float* S = (const LAS float*)lds + 1024;
        const int col0 = u.pn * 256 + wc * 32 + 8 * fq;
        u32x4 hv0[4][2]; float rp[2][4]; f32x4 gi[2][2];
#pragma unroll
        for (int m = 0; m < 4; ++m)
#pragma unroll
            for (int bj = 0; bj < 2; ++bj) hv0[m][bj] = *(const u32x4*)(H + (size_t)(u.pm * 256 + wr * 64 + m * 16 + fr) * 1024 + col0 + bj * 128);
#pragma unroll
        for (int ai = 0; ai < 2; ++ai)
#pragma unroll
            for (int m = 0; m < 4; ++m) rp[ai][m] = RS[u.pm * 256 + ai * 128 + wr * 64 + m * 16 + fr];
#pragma unroll
        for (int bj = 0; bj < 2; ++bj)
#pragma unroll
            for (int n = 0; n < 2; ++n) gi[bj][n] = *(const f32x4*)(gprev + col0 + bj * 128 + n * 4);
        __builtin_amdgcn_sched_barrier(0);
        row_rs(acc, u, wr, wc, fr, fq, lds, tid, xb1, cnt1);
#pragma unroll
        for (int ai = 0; ai < 2; ++ai)
#pragma unroll
            for (int m = 0; m < 4; ++m) rp[ai][m] = __builtin_amdgcn_rcpf(rp[ai][m]);
#pragma unroll
        for (int bj = 0; bj < 2; ++bj)
#pragma unroll
            for (int n = 0; n < 2; ++n)
#pragma unroll
                for (int e = 0; e < 4; ++e) gi[bj][n][e] = __builtin_amdgcn_rcpf(gi[bj][n][e]);
        f32x4 gp[2][2];
#pragma unroll
        for (int bj = 0; bj < 2; ++bj)
#pragma unroll
            for (int n = 0; n < 2; ++n) gp[bj][n] = *(const f32x4*)(gpost + col0 + bj * 128 + n * 4);
#pragma unroll
        for (int ai = 0; ai < 2; ++ai) {
            u32x4 hv[4][2];
#pragma unroll
            for (int m = 0; m < 4; ++m)
#pragma unroll
                for (int bj = 0; bj < 2; ++bj) hv[m][bj] = (ai == 0) ? hv0[m][bj] : *(const u32x4*)(H + (size_t)(u.pm * 256 + 128 + wr * 64 + m * 16 + fr) * 1024 + col0 + bj * 128);
            __builtin_amdgcn_sched_barrier(0);
#pragma unroll
            for (int m = 0; m < 4; ++m) { const float rs = S[ai * 128 + wr * 64 + m * 16 + fr];
#pragma unroll
                for (int bj = 0; bj < 2; ++bj) { const u32x4 hh = hv[m][bj];
                    const f32x4 x0 = (f32x4){bf_lo(hh.x), bf_hi(hh.x), bf_lo(hh.y), bf_hi(hh.y)} * gi[bj][0] * rp[ai][m], x1 = (f32x4){bf_lo(hh.z), bf_hi(hh.z), bf_lo(hh.w), bf_hi(hh.w)} * gi[bj][1] * rp[ai][m];
                    acc[ai][bj][m][0] = x0 + (acc[ai][bj][m][0] * rs) * gp[bj][0]; acc[ai][bj][m][1] = x1 + (acc[ai][bj][m][1] * rs) * gp[bj][1]; } }
            __builtin_amdgcn_sched_barrier(0);
        }
        if (!last) {
            __syncthreads();
            row_rs(acc, u, wr, wc, fr, fq, lds, tid, xb2, cnt2);
            if (u.pn == 0 && tid < 256) RS[u.pm * 256 + tid] = S[tid];
#pragma unroll
            for (int bj = 0; bj < 2; ++bj)
#pragma unroll
                for (int n = 0; n < 2; ++n) gp[bj][n] = *(const f32x4*)(gpre + col0 + bj * 128 + n * 4);
        }
#pragma unroll
        for (int ai = 0; ai < 2; ++ai)
#pragma unroll
            for (int m = 0; m < 4; ++m) { const int rl = ai * 128 + wr * 64 + m * 16 + fr; const size_t off = (size_t)(u.pm * 256 + rl) * 1024 + col0; const float rs2 = S[rl];
#pragma unroll
                for (int bj = 0; bj < 2; ++bj) { const f32x4 x0 = acc[ai][bj][m][0], x1 = acc[ai][bj][m][1];
                    if (last) { __builtin_nontemporal_store(x0, (f32x4*)(y + off + bj * 128)); __builtin_nontemporal_store(x1, (f32x4*)(y + off + bj * 128 + 4)); }
                    else { const f32x4 h0 = (x0 * rs2) * gp[bj][0], h1 = (x1 * rs2) * gp[bj][1]; u32x4 w; w.x = cvt_pk_bf16(h0[0], h0[1]); w.y = cvt_pk_bf16(h0[2], h0[3]); w.z = cvt_pk_bf16(h1[0], h1[1]); w.w = cvt_pk_bf16(h1[2], h1[3]);
                        *(u32x4*)(H + off + bj * 128) = w; } } }
    }
};

struct TrItem { const float* W; bf16_t* WT; int K, N, item; bool remap; };
__device__ __forceinline__ void tr_load(const TrItem& T, int lane, float (&wr_)[32]) {
    const int nblk = T.N / 32, kb = T.item / nblk, nb = T.item % nblk, k0 = 64 * kb, n0 = 32 * nb;
#pragma unroll
    for (int i = 0; i < 32; ++i) { const int kk = 2 * i + (lane >> 5); wr_[i] = __builtin_nontemporal_load(&T.W[(size_t)(k0 + kk) * T.N + n0 + (lane & 31)]); }
    __builtin_amdgcn_sched_barrier(0);
}
__device__ __forceinline__ void tr_finish(const TrItem& T, LAS float* scr, int lane, const float (&wr_)[32]) {
    const int nblk = T.N / 32, kb = T.item / nblk, nb = T.item % nblk, k0 = 64 * kb, n0 = 32 * nb;
    int r0 = n0;
    if (T.remap && n0 >= ZC_CA && n0 < ZC_GC) r0 = (n0 < ZC_CB) ? zc_ca(n0 - ZC_CA) : zc_ca(n0 - ZC_CB) + 128;
#pragma unroll
    for (int i = 0; i < 32; ++i) { const int kk = 2 * i + (lane >> 5); scr[kk * 33 + (lane & 31)] = wr_[i]; }
    LDS_WAIT(); asm volatile("" ::: "memory");
    const int c = lane & 7;
#pragma unroll
    for (int j = 0; j < 4; ++j) { const int n = (lane >> 3) + 8 * j; const LAS float* s = scr + (8 * c) * 33 + n;
        u32x4 o; o.x = cvt_pk_bf16(s[0 * 33], s[1 * 33]); o.y = cvt_pk_bf16(s[2 * 33], s[3 * 33]); o.z = cvt_pk_bf16(s[4 * 33], s[5 * 33]); o.w = cvt_pk_bf16(s[6 * 33], s[7 * 33]);
        *(u32x4*)(T.WT + (size_t)(r0 + n) * T.K + k0 + 8 * c) = o; }
    LDS_WAIT(); asm volatile("" ::: "memory");
}
__device__ __forceinline__ TrItem tr_decode(Ctx& X, int it) {
    constexpr int I_IN = (1024 / 64) * (ZN / 32), I_AO = (768 / 64) * (1024 / 32);
    constexpr int PER_L = I_IN + 2 * I_AO + (1024 / 64) * (1024 / 32);
    const int l = it / PER_L; int r = it % PER_L; TrItem T;
    if (r < I_IN) { T.W = X.in[9] + (size_t)l * 1024 * ZN; T.WT = (bf16_t*)(X.ws + WS_WIN + l * SZ_WIN1); T.K = 1024; T.N = ZN; T.item = r; T.remap = true; return T; } r -= I_IN;
    if (r < I_AO) { T.W = X.in[10] + (size_t)l * 768 * 1024; T.WT = (bf16_t*)(X.ws + WS_WAO + l * SZ_WAO1); T.K = 768; T.N = 1024; T.item = r; T.remap = false; return T; } r -= I_AO;
    if (r < I_AO) { T.W = X.in[11] + (size_t)l * 768 * 1024; T.WT = (bf16_t*)(X.ws + WS_WCO + l * SZ_WAO1); T.K = 768; T.N = 1024; T.item = r; T.remap = false; return T; } r -= I_AO;
    T.W = X.in[12] + (size_t)l * 1024 * 1024; T.WT = (bf16_t*)(X.ws + WS_WO + l * SZ_WO1); T.K = 1024; T.N = 1024; T.item = r; T.remap = false; return T;
}
__device__ __forceinline__ void weight_transposes(Ctx& X, int gw0, int ngw) {
    LAS float* scr = (LAS float*)(X.lds + X.wave * 16384);
    constexpr int NITEMS = 4 * ((1024 / 64) * (ZN / 32) + 2 * (768 / 64) * (1024 / 32) + (1024 / 64) * (1024 / 32));
    int it = gw0; if (it >= NITEMS) return;
    float ra[32], rb[32];
    TrItem Tc = tr_decode(X, it); tr_load(Tc, X.lane, ra);
#pragma unroll 1
    for (;;) {
        const int itn = it + ngw; const bool more = itn < NITEMS;
        TrItem Tn = Tc; if (more) { Tn = tr_decode(X, itn); tr_load(Tn, X.lane, rb); }
        tr_finish(Tc, scr, X.lane, ra);
        if (!more) break;
#pragma unroll
        for (int i = 0; i < 32; ++i) ra[i] = rb[i];
        Tc = Tn; it = itn;
    }
}
__device__ __forceinline__ void rms_row_to_bf16(const float* xrow, const float* g, bf16_t* orow, int lane, float* rs_out) {
    const f32x4* xr = (const f32x4*)xrow + lane; const f32x4* gr = (const f32x4*)g + lane;
    f32x4 v[4], gv[4]; float s = 0.f;
#pragma unroll
    for (int j = 0; j < 4; ++j) { v[j] = xr[64 * j]; gv[j] = gr[64 * j]; }
    __builtin_amdgcn_sched_barrier(0);
#pragma unroll
    for (int j = 0; j < 4; ++j) s += (v[j].x * v[j].x + v[j].y * v[j].y) + (v[j].z * v[j].z + v[j].w * v[j].w);
    const float rs = 1.0f / sqrtf(wave_sum(s) * (1.f / 1024.f) + RMS_EPS);
    if (rs_out && lane == 0) *rs_out = rs;
    u32x2* o8 = (u32x2*)orow + lane;
#pragma unroll
    for (int j = 0; j < 4; ++j) { const f32x4 gg = gv[j]; u32x2 w; w.x = cvt_pk_bf16(v[j].x * rs * gg.x, v[j].y * rs * gg.y); w.y = cvt_pk_bf16(v[j].z * rs * gg.z, v[j].w * rs * gg.w); o8[64 * j] = w; }
}
__device__ __forceinline__ void p0_prep(Ctx& X) {
    const int gw = X.vcu * NWAVES + X.wave, NGW = X.G * NWAVES;
    weight_transposes(X, gw, NGW);
    {
        float* rope = (float*)(X.ws + WS_ROPE);
        const int gt = X.vcu * 512 + X.tid, NT = X.G * 512;
        for (int i = gt; i < 2049 * 8; i += NT) {
            const int pidx = i >> 3, e = i & 7; const int pos = (pidx < 2048) ? pidx : 8192;
            const float inv = e == 0 ? 1.0f : e == 1 ? 0.19392274474868576f : e == 2 ? 0.03760603093086393f : e == 3 ? 0.007292664737217109f : e == 4 ? 0.001414213562373095f
                            : e == 5 ? 0.0002742481756762073f : e == 6 ? 5.318295896944988e-05f : 1.031338537721246e-05f;
            const float ang = (float)pos * inv;
            const float k = rintf(ang * 0.15915494309189535f);
            float r = fmaf(-k, 6.2831854820251465f, ang); r = fmaf(-k, -1.7484556025237907e-07f, r);
            const float rev = r * 0.15915494309189535f;
            rope[pidx * 16 + e] = __builtin_amdgcn_cosf(rev); rope[pidx * 16 + 8 + e] = __builtin_amdgcn_sinf(rev);
        }
    }
    {
        float* cwt = (float*)(X.ws + WS_CWT);
        const int gt = X.vcu * 512 + X.tid, NT = X.G * 512;
        for (int i = gt; i < 4 * 768 * 32; i += NT) { const int l = i / (768 * 32), r = i % (768 * 32), c = r >> 5, k = r & 31; cwt[i] = (k < 31) ? X.in[13][((size_t)l * 31 + k) * 768 + c] : 0.f; }
    }
    {
        bf16_t* H = (bf16_t*)(X.ws + WS_H);
        for (int m = gw; m < MPAD; m += NGW) {
            if (m < MR) { const float* xr = (m < MP) ? X.in[0] + (size_t)m * 1024 : X.in[1] + (size_t)(m - MP) * 1024; rms_row_to_bf16(xr, X.in[16], H + (size_t)m * 1024, X.lane, (m < MP) ? (float*)(X.ws + WS_RS) + m : nullptr); }
            else { u32x4* o = (u32x4*)(H + (size_t)m * 1024) + X.lane; o[0] = (u32x4){0u, 0u, 0u, 0u}; o[64] = (u32x4){0u, 0u, 0u, 0u}; }
        }
    }
}

__device__ __forceinline__ int crow(int r, int hi) { return (r & 3) + 8 * (r >> 2) + 4 * hi; }
__device__ __forceinline__ s16x4 vtr(LAS const unsigned char* p) { typedef short v4i16_t __attribute__((ext_vector_type(4))); return __builtin_bit_cast(s16x4, __builtin_amdgcn_ds_read_tr16_b64_v4i16((LAS v4i16_t*)p)); }

__device__ __forceinline__ void conv_issue(const bf16_t* Z, int unit, int tid, u32x4 (&ra)[12]);
struct AttnGeo { int h, dsh, c0, tb0, tw0, two; };
__device__ __forceinline__ AttnGeo attn_geo(int u) {
    AttnGeo G; G.h = u >> 3; const int sub = u & 7, g = G.h >> 2; G.dsh = 2 * g;
    if (g == 0) { G.c0 = 0; G.tb0 = 8 * sub; G.tw0 = 256 * sub - 128; G.two = 0; }
    else if (g == 1) { G.c0 = sub >> 1; G.tb0 = 8 * (sub & 1); G.tw0 = 256 * (sub & 1) - 128; G.two = 0; }
    else { G.c0 = 2 * sub; G.tb0 = 0; G.tw0 = 0; G.two = 1; }
    return G;
}
constexpr int AT_OST = 98304, AT_SCR = 131072;
__device__ __forceinline__ void attn_issue(const bf16_t* Z, int b, int u, int tid, u32x4 (&pf)[12]) {
    const AttnGeo G = attn_geo(u);
    const size_t rowb = (size_t)b * 2048; const int isv = tid >> 8, ch = tid & 255, key = ch >> 3, dch = ch & 7;
    const int col = (isv ? ZC_V : ZC_K) + G.h * 64 + dch * 8;
#pragma unroll
    for (int s = 0; s < 12; ++s) {
        int t, c; if (G.two) { t = 32 * (s & 3) + key; c = G.c0 + (s >> 2); } else { t = G.tw0 + 32 * s + key; c = G.c0; }
        const bool ok = G.two ? (s < 8) : (t >= 0);
        const size_t m = rowb + ((size_t)(ok ? t : 0) << G.dsh) + c;
        pf[s] = ok ? __builtin_nontemporal_load((const u32x4*)(Z + m * ZN + col)) : (u32x4){0u, 0u, 0u, 0u};
    }
    __builtin_amdgcn_sched_barrier(0);
}
__device__ __forceinline__ void attn_issue_q(const bf16_t* Z, int b, int u, int wave, int lane, bf16x8 (&qn)[4]) {
    const AttnGeo G = attn_geo(u); const size_t rowb = (size_t)b * 2048;
    const int r32 = lane & 31, hi = lane >> 5;
    const int cw = G.two ? G.c0 + (wave >> 2) : G.c0, tb = G.two ? (wave & 3) : G.tb0 + wave;
    const size_t mq = rowb + ((size_t)(tb * 32 + r32) << G.dsh) + cw;
#pragma unroll
    for (int d0 = 0; d0 < 4; ++d0) qn[d0] = *(const bf16x8*)(Z + mq * ZN + ZC_Q + G.h * 64 + d0 * 16 + hi * 8);
    __builtin_amdgcn_sched_barrier(0);
}
__device__ __forceinline__ void attn_stage_write(LAS unsigned char* lds, int tid, const u32x4 (&pf)[12]) {
    const int isv = tid >> 8, ch = tid & 255, key = ch >> 3, dch = ch & 7;
    const int off = isv ? 4096 + (dch >> 2) * 2048 + (key >> 4) * 1024 + ((key >> 3) & 1) * 512 + (key & 7) * 64 + (dch & 3) * 16 : key * 128 + ((dch ^ (key & 7)) << 4);
#pragma unroll
    for (int s = 0; s < 12; ++s) *(LAS u32x4*)(lds + s * 8192 + off) = pf[s];
}
__device__ __forceinline__ void attn_compute(const bf16_t* Z, bf16_t* A2, float* LSE, int b, int u, int un, LAS unsigned char* lds, int tid, int wave, int lane, u32x4 (&pf)[12], bf16x8 (&qr)[4], int cunit) {
    const AttnGeo G = attn_geo(u);
    const int r32 = lane & 31, hi = lane >> 5; const int h = G.h, dsh = G.dsh;
    const int c = G.two ? G.c0 + (wave >> 2) : G.c0, tb = G.two ? (wave & 3) : G.tb0 + wave;
    const int sl0 = G.two ? 4 * (wave >> 2) + (wave & 3) - 4 : wave;
    const size_t rowb = (size_t)b * 2048; const size_t mq = rowb + ((size_t)(tb * 32 + r32) << dsh) + c;
    const int jlo = tb >= 4 ? 0 : 4 - tb;
    f32x16 S[5]; const float NEG = -INFINITY;
#pragma unroll
    for (int j = 0; j < 5; ++j) {
        if (j >= jlo) {
            const LAS unsigned char* kb = lds + (sl0 + j) * 8192 + r32 * 128;
            bf16x8 kf[4];
#pragma unroll
            for (int d0 = 0; d0 < 4; ++d0) kf[d0] = *(const LAS bf16x8*)(kb + (((2 * d0 + hi) ^ (r32 & 7)) << 4));
            f32x16 a = {};
#pragma unroll
            for (int d0 = 0; d0 < 4; ++d0) a = __builtin_amdgcn_mfma_f32_32x32x16_bf16(kf[d0], qr[d0], a, 0, 0, 0);
            S[j] = a;
        } else {
#pragma unroll
            for (int r = 0; r < 16; ++r) S[j][r] = NEG;
        }
    }
    if (jlo == 0) {
#pragma unroll
        for (int r = 0; r < 16; ++r) if (crow(r, hi) < r32) S[0][r] = NEG;
    }
#pragma unroll
    for (int r = 0; r < 16; ++r) if (crow(r, hi) > r32) S[4][r] = NEG;
    float mx = NEG;
#pragma unroll
    for (int j = 0; j < 5; ++j)
#pragma unroll
        for (int r = 0; r < 16; ++r) mx = fmaxf(mx, S[j][r]);
    mx = fmaxf(mx, __shfl_xor(mx, 32));
    float l = 0.f;
#pragma unroll
    for (int j = 0; j < 5; ++j)
#pragma unroll
        for (int r = 0; r < 16; ++r) { const float p = __builtin_amdgcn_exp2f(S[j][r] - mx); S[j][r] = p; l += p; }
    l += __shfl_xor(l, 32);
    LAS float* scr = (LAS float*)(lds + AT_SCR + wave * 256);
    if (hi == 0) { scr[r32] = __builtin_amdgcn_rcpf(l); LSE[(mq * 4 + (h & 3)) * 4 + (h >> 2)] = (mx + __builtin_amdgcn_logf(l)) * LN2; }
    u32x4 pw[5][2];
#pragma unroll
    for (int j = 0; j < 5; ++j)
#pragma unroll
        for (int s = 0; s < 2; ++s) { pw[j][s].x = cvt_pk_bf16(S[j][8 * s + 0], S[j][8 * s + 1]); pw[j][s].y = cvt_pk_bf16(S[j][8 * s + 2], S[j][8 * s + 3]); pw[j][s].z = cvt_pk_bf16(S[j][8 * s + 4], S[j][8 * s + 5]); pw[j][s].w = cvt_pk_bf16(S[j][8 * s + 6], S[j][8 * s + 7]); }
    __builtin_amdgcn_sched_barrier(0);
    if (un < 96) attn_issue(Z, b, un, tid, pf);
    else conv_issue(Z, cunit, tid, pf);
    f32x16 o0 = {}, o1 = {};
    const int vrd = 4096 + (4 * hi + ((lane & 15) >> 2)) * 64 + ((lane >> 4) & 1) * 32 + (lane & 3) * 8;
#pragma unroll
    for (int j = 0; j < 5; ++j) {
        if (j >= jlo) {
            const LAS unsigned char* vb = lds + (sl0 + j) * 8192 + vrd;
#pragma unroll
            for (int s = 0; s < 2; ++s) {
                const bf16x8 pa = __builtin_bit_cast(bf16x8, pw[j][s]);
                { const s16x4 lo = vtr(vb + s * 1024), hh = vtr(vb + s * 1024 + 512);
                  const bf16x8 vf = (bf16x8){lo[0], lo[1], lo[2], lo[3], hh[0], hh[1], hh[2], hh[3]};
                  o0 = __builtin_amdgcn_mfma_f32_32x32x16_bf16(pa, vf, o0, 0, 0, 0); }
                { const s16x4 lo = vtr(vb + 2048 + s * 1024), hh = vtr(vb + 2048 + s * 1024 + 512);
                  const bf16x8 vf = (bf16x8){lo[0], lo[1], lo[2], lo[3], hh[0], hh[1], hh[2], hh[3]};
                  o1 = __builtin_amdgcn_mfma_f32_32x32x16_bf16(pa, vf, o1, 0, 0, 0); }
            }
        }
    }
    LDS_WAIT();
    LAS bf16_t* stg = (LAS bf16_t*)(lds + AT_OST + wave * 4096);
#pragma unroll
    for (int r = 0; r < 16; ++r) { const int orow = crow(r, hi); const float rl = scr[orow];
        stg[orow * 64 + r32] = (bf16_t)(cvt_pk_bf16(o0[r] * rl, 0.f) & 0xffffu); stg[orow * 64 + 32 + r32] = (bf16_t)(cvt_pk_bf16(o1[r] * rl, 0.f) & 0xffffu); }
    LDS_WAIT();
#pragma unroll
    for (int i = 0; i < 4; ++i) { const int row = i * 8 + (lane >> 3), ch = lane & 7; const u32x4 v = *(const LAS u32x4*)(stg + row * 64 + ch * 8);
        const size_t mo = rowb + ((size_t)(tb * 32 + row) << dsh) + c;
        *(u32x4*)(A2 + mo * AW + h * 64 + ch * 8) = v; }
    LDS_WAIT();
}
__device__ __forceinline__ void attn_prompt_wg(Ctx& X, const bf16_t* Z, bf16_t* A2, float* LSE, int b, u32x4 (&pf)[12], int cunit) {
    attn_issue(Z, b, X.rank, X.tid, pf);
#pragma unroll 1
    for (int u = X.rank; u < 96; u += 32) {
        bf16x8 qr[4];
        attn_issue_q(Z, b, u, X.wave, X.lane, qr);
        attn_stage_write(X.lds, X.tid, pf);
        __syncthreads();
        attn_compute(Z, A2, LSE, b, u, u + 32, X.lds, X.tid, X.wave, X.lane, pf, qr, cunit);
        __syncthreads();
    }
}

__device__ __forceinline__ void attn_sample_unit3(const bf16_t* Z, const float* const* in, bf16_t* A2, int layer, int unit, LAS unsigned char* wl, int lane) {
    const int b = unit >> 2, hs = unit & 3;
    const size_t m = (size_t)MP + b;
    const bf16_t* zr = Z + m * ZN;
    LAS float* sc = (LAS float*)wl;
    const int sub = lane >> 4, e = lane & 15;
    f32x4 og[3]; float lse[3];
#pragma unroll
    for (int g = 0; g < 3; ++g) {
        const int h = g * 4 + hs; const int dsh = 2 * g, d = 1 << dsh, W = 128 << dsh;
        const float* cK = in[2 + 2 * g] + ((size_t)(layer * 32 + b) * W) * 256 + hs * 64;
        const float* cV = in[3 + 2 * g] + ((size_t)(layer * 32 + b) * W) * 256 + hs * 64;
        const unsigned voff = (unsigned)(((3 - sub) * d) * 256 + 4 * e) * 4u;
        const size_t rstep = (size_t)(4 * d) * 256 * 4;
        const char* kb = (const char*)(cK + (size_t)(W - 4 * d) * 256);
        const char* vb = (const char*)(cV + (size_t)(W - 4 * d) * 256);
        f32x4 q4; { const u32x2 qq = *(const u32x2*)(zr + ZC_Q + h * 64 + 4 * e); q4 = (f32x4){bf_lo(qq.x), bf_hi(qq.x), bf_lo(qq.y), bf_hi(qq.y)}; }
        f32x4 kn4; { const u32x2 kk = *(const u32x2*)(zr + ZC_K + h * 64 + 4 * e); kn4 = (f32x4){bf_lo(kk.x), bf_hi(kk.x), bf_lo(kk.y), bf_hi(kk.y)}; }
        f32x4 vn4; { const u32x2 vv = *(const u32x2*)(zr + ZC_V + h * 64 + 4 * e); vn4 = (f32x4){bf_lo(vv.x), bf_hi(vv.x), bf_lo(vv.y), bf_hi(vv.y)}; }
        float pr[32];
        {
            f32x4 k4[32];
#pragma unroll
            for (int it = 0; it < 32; ++it) k4[it] = *(const f32x4*)(kb - (size_t)it * rstep + voff);
            __builtin_amdgcn_sched_barrier(0);
#pragma unroll
            for (int it = 0; it < 32; ++it) pr[it] = (q4.x * k4[it].x + q4.y * k4[it].y) + (q4.z * k4[it].z + q4.w * k4[it].w);
        }
        f32x4 v4[32];
#pragma unroll
        for (int it = 0; it < 32; ++it) v4[it] = *(const f32x4*)(vb - (size_t)it * rstep + voff);
        asm volatile("" ::: "memory"); __builtin_amdgcn_sched_barrier(0);
#pragma unroll
        for (int s = 0; s < 4; ++s) {
            const int half = 16 >> s; const unsigned msk = 0u - (unsigned)((lane >> s) & 1);
#pragma unroll
            for (int i = 0; i < half; ++i) { const unsigned ua = __float_as_uint(pr[i]), ub = __float_as_uint(pr[i + half]);
                const float send = __uint_as_float((ua & msk) | (ub & ~msk)); const float keep = __uint_as_float((ub & msk) | (ua & ~msk)); pr[i] = keep + __shfl_xor(send, 1 << s); }
        }
        { const int it0 = 16 * (e & 1) + 8 * ((e >> 1) & 1) + 4 * ((e >> 2) & 1) + 2 * ((e >> 3) & 1);
          sc[4 * it0 + sub + 1] = pr[0]; sc[4 * (it0 + 1) + sub + 1] = pr[1]; }
        { float p0 = (q4.x * kn4.x + q4.y * kn4.y) + (q4.z * kn4.z + q4.w * kn4.w);
          p0 += __shfl_xor(p0, 1); p0 += __shfl_xor(p0, 2); p0 += __shfl_xor(p0, 4); p0 += __shfl_xor(p0, 8); if (lane == 0) sc[0] = p0; }
        LDS_WAIT();
        const float sa = sc[lane], sb = sc[lane + 64], scc = (lane == 0) ? sc[128] : -INFINITY;
        const float mx = wave_max(fmaxf(fmaxf(sa, sb), scc));
        const float pa = __builtin_amdgcn_exp2f(sa - mx), pb = __builtin_amdgcn_exp2f(sb - mx), pc = __builtin_amdgcn_exp2f(scc - mx);
        const float l = wave_sum(pa + pb + pc);
        LDS_WAIT();
        sc[lane] = pa; sc[lane + 64] = pb; if (lane == 0) sc[128] = pc;
        LDS_WAIT();
        f32x4 acc = {0.f, 0.f, 0.f, 0.f};
#pragma unroll
        for (int it = 0; it < 32; ++it) { const float p = sc[4 * it + sub + 1]; acc = acc + v4[it] * p; }
#pragma unroll
        for (int k = 0; k < 4; ++k) { acc[k] += __shfl_xor(acc[k], 16); acc[k] += __shfl_xor(acc[k], 32); }
        { const float p0 = sc[0]; acc = acc + vn4 * p0; }
        og[g] = acc * (1.0f / l);
        lse[g] = (mx + __builtin_amdgcn_logf(l)) * LN2;
        LDS_WAIT();
        asm volatile("" ::: "memory");
    }
    const float lm = fmaxf(lse[0], fmaxf(lse[1], lse[2]));
    const float e0 = __expf(lse[0] - lm), e1 = __expf(lse[1] - lm), e2 = __expf(lse[2] - lm); const float rs = 1.0f / (e0 + e1 + e2);
    const float al[3] = {e0 * rs, e1 * rs, e2 * rs};
    if (sub == 0) {
#pragma unroll
        for (int g = 0; g < 3; ++g) { const int h = g * 4 + hs; const u32x2 ga = *(const u32x2*)(zr + ZC_GA + h * 64 + 4 * e);
            u32x2 w; w.x = cvt_pk_bf16(og[g].x * al[g] * siluf_(bf_lo(ga.x)), og[g].y * al[g] * siluf_(bf_hi(ga.x))); w.y = cvt_pk_bf16(og[g].z * al[g] * siluf_(bf_lo(ga.y)), og[g].w * al[g] * siluf_(bf_hi(ga.y)));
            st_wt64(A2 + m * AW + h * 64 + 4 * e, w); }
    }
}

__device__ __forceinline__ void bfly32(float (&v)[32], int lane) {
#pragma unroll
    for (int s = 0; s < 5; ++s) {
        const int half = 16 >> s; const unsigned msk = 0u - (unsigned)((lane >> s) & 1);
#pragma unroll
        for (int i = 0; i < half; ++i) { const unsigned ua = __float_as_uint(v[i]), ub = __float_as_uint(v[i + half]);
            const float send = __uint_as_float((ua & msk) | (ub & ~msk)); const float keep = __uint_as_float((ub & msk) | (ua & ~msk)); v[i] = keep + __shfl_xor(send, 1 << s); }
    }
    v[0] += __shfl_xor(v[0], 32);
}
__device__ __forceinline__ int bfly_idx(int lane) { return 16 * (lane & 1) + 8 * ((lane >> 1) & 1) + 4 * ((lane >> 2) & 1) + 2 * ((lane >> 3) & 1) + ((lane >> 4) & 1); }

constexpr int CV_U = 0, CV_STAT = 98304, CV_FIN = CV_STAT + 8 * 32 * 4, CV_W = 100352;
static_assert(CV_W + 8 * 768 * 8 <= LDSCTL_OFF, "conv LDS map");
__device__ __forceinline__ void conv_issue(const bf16_t* Z, int unit, int tid, u32x4 (&ra)[12]) {
    const int b = unit >> 6, s0 = (unit & 63) * 32;
#pragma unroll
    for (int q = 0; q < 12; ++q) { const int ci = tid + 512 * q; const int lr = ci / 96, ch = ci - lr * 96; const int s = s0 - 30 + lr;
        if (ci < 62 * 96 && s >= 0) ra[q] = *(const u32x4*)(Z + ((size_t)b * 2048 + s) * ZN + zc_ca(ch * 8));
        else ra[q] = (u32x4){0u, 0u, 0u, 0u}; }
    __builtin_amdgcn_sched_barrier(0);
}
__device__ __forceinline__ void conv_prompt_wg(Ctx& X, const bf16_t* Z, bf16_t* C2, int layer, int unit0, u32x4 (&ra)[12]) {
    const int tid = X.tid, lane = X.lane;
    const float* cwt = (const float*)(X.ws + WS_CWT) + (size_t)layer * 768 * 32;
    const float* lg = X.in[14] + (size_t)layer * CW; const float* lb = X.in[15] + (size_t)layer * CW;
    LAS bf16_t* U = (LAS bf16_t*)(X.lds + CV_U);
    const int cidx = tid & 255, th = tid >> 8;
    { LAS unsigned char* Wl = X.lds + CV_W;
#pragma unroll
      for (int h = 0; h < 2; ++h) {
        f32x4 wt[6];
#pragma unroll
        for (int k = 0; k < 6; ++k) wt[k] = *(const f32x4*)(cwt + (size_t)(tid + 512 * (6 * h + k)) * 4);
        __builtin_amdgcn_sched_barrier(0);
#pragma unroll
        for (int k = 0; k < 6; ++k) { const int idx = tid + 512 * (6 * h + k), c = idx >> 3, g = idx & 7; u32x2 w; w.x = cvt_pk_bf16(wt[k].x, wt[k].y); w.y = cvt_pk_bf16(wt[k].z, wt[k].w); *(LAS u32x2*)(Wl + (g * 768 + c) * 8) = w; }
        __builtin_amdgcn_sched_barrier(0);
      } }
#pragma unroll
    for (int iter = 0; iter < 2; ++iter) {
        const int unit = unit0 + 32 * iter; const int b = unit >> 6, s0 = (unit & 63) * 32;
        u32x4 gcv[6];
#pragma unroll
        for (int q = 0; q < 6; ++q) { const int ci = tid + 512 * q; const int tl = ci / 96, ch = ci - tl * 96; const size_t m = (size_t)b * 2048 + s0 + tl; gcv[q] = __builtin_nontemporal_load((const u32x4*)(Z + m * ZN + ZC_GC + ch * 8)); }
#pragma unroll
        for (int q = 0; q < 12; ++q) { const int ci = tid + 512 * q; const int lr = ci / 96, ch = ci - lr * 96;
            if (ci < 62 * 96) *(LAS u32x4*)(U + lr * 768 + ch * 8) = ra[q]; }
        __syncthreads();
        float cd[3][16];
#pragma unroll
        for (int k = 0; k < 3; ++k) {
            const int c = cidx + 256 * k;
            u32x2 wq[8];
            { const LAS unsigned char* Wl = X.lds + CV_W + c * 8;
#pragma unroll
              for (int g = 0; g < 8; ++g) wq[g] = *(const LAS u32x2*)(Wl + g * 768 * 8); }
            float uu[46];
#pragma unroll
            for (int j = 0; j < 46; ++j) uu[j] = bf1(U[(th * 16 + j) * 768 + c]);
#pragma unroll
            for (int t = 0; t < 16; ++t) cd[k][t] = 0.f;
#pragma unroll
            for (int i = 0; i < 31; ++i) {
                const unsigned wp = (i & 2) ? wq[i >> 2].y : wq[i >> 2].x; const float w = (i & 1) ? bf_hi(wp) : bf_lo(wp);
#pragma unroll
                for (int t = 0; t < 16; ++t) cd[k][t] += uu[t + i] * w; }
            asm volatile("" ::: "memory"); __builtin_amdgcn_sched_barrier(0);
        }
        float st[32];
#pragma unroll
        for (int t = 0; t < 16; ++t) { st[2 * t] = cd[0][t] + cd[1][t] + cd[2][t]; st[2 * t + 1] = cd[0][t] * cd[0][t] + cd[1][t] * cd[1][t] + cd[2][t] * cd[2][t]; }
        bfly32(st, lane);
        LAS float* part = (LAS float*)(X.lds + CV_STAT);
        LAS float* fin = (LAS float*)(X.lds + CV_FIN);
        if (lane < 32) part[X.wave * 32 + bfly_idx(lane)] = st[0];
        __syncthreads();
        if (iter == 0) conv_issue(Z, unit0 + 32, tid, ra);
        if (tid < 64) {
            const int hf = tid >> 5, idx = tid & 31;
            const float tot = part[(hf * 4 + 0) * 32 + idx] + part[(hf * 4 + 1) * 32 + idx] + part[(hf * 4 + 2) * 32 + idx] + part[(hf * 4 + 3) * 32 + idx];
            const float oth = __shfl_xor(tot, 1);
            const float s1 = (idx & 1) ? oth : tot, s2 = (idx & 1) ? tot : oth;
            float inv768 = 1.f / 768.f; asm volatile("" : "+v"(inv768));
            const float mean = s1 * inv768; const float var = fmaxf(s2 * inv768 - mean * mean, 0.f);
            fin[hf * 32 + idx] = (idx & 1) ? (1.0f / sqrtf(var + LN_EPS)) : mean;
        }
        __syncthreads();
        LAS bf16_t* Y = (LAS bf16_t*)(X.lds + CV_U);
#pragma unroll
        for (int k = 0; k < 3; ++k) {
            const int c = cidx + 256 * k; const float gg = lg[c], bb = lb[c];
#pragma unroll
            for (int t = 0; t < 16; ++t) {
                const float mean = fin[th * 32 + 2 * t], rstd = fin[th * 32 + 2 * t + 1];
                const float y = (cd[k][t] - mean) * rstd * gg + bb;
                Y[(th * 16 + t) * 768 + c] = (bf16_t)(cvt_pk_bf16(siluf_(y), 0.f) & 0xffffu);
            }
        }
        __syncthreads();
#pragma unroll
        for (int q = 0; q < 6; ++q) {
            const int ci = tid + 512 * q;
            const int tl = ci / 96, ch = ci - tl * 96; const size_t m = (size_t)b * 2048 + s0 + tl;
            const u32x4 y = *(const LAS u32x4*)(Y + tl * 768 + ch * 8); const u32x4 gc = gcv[q];
            u32x4 w;
            w.x = cvt_pk_bf16(bf_lo(y.x) * siluf_(bf_lo(gc.x)), bf_hi(y.x) * siluf_(bf_hi(gc.x))); w.y = cvt_pk_bf16(bf_lo(y.y) * siluf_(bf_lo(gc.y)), bf_hi(y.y) * siluf_(bf_hi(gc.y)));
            w.z = cvt_pk_bf16(bf_lo(y.z) * siluf_(bf_lo(gc.z)), bf_hi(y.z) * siluf_(bf_hi(gc.z))); w.w = cvt_pk_bf16(bf_lo(y.w) * siluf_(bf_lo(gc.w)), bf_hi(y.w) * siluf_(bf_hi(gc.w)));
            *(u32x4*)(C2 + m * CW + ch * 8) = w;
        }
        __syncthreads();
    }
}

__device__ __forceinline__ void conv_sample_pair(Ctx& X, const bf16_t* Z, bf16_t* C2, int layer, int b0) {
    const float* cwt = (const float*)(X.ws + WS_CWT) + (size_t)layer * 768 * 32;
    const float* lg = X.in[14] + (size_t)layer * CW; const float* lb = X.in[15] + (size_t)layer * CW;
    const int half = X.tid >> 8, ct = X.tid & 255; const int b = b0 + half * NSVC; const bool act = b < DEC_BATCH; const int bb = act ? b : b0;
    const char* stt = (const char*)(X.in[8] + ((size_t)(layer * 32 + bb) * 30) * 768);
    char* sco = (char*)(X.out + O_SC + ((size_t)(layer * 32 + bb) * 30) * 768);
    const size_t m = (size_t)MP + bb; const bf16_t* zr = Z + m * ZN;
    LAS float* red = (LAS float*)(X.lds + CV_STAT);
    float cd[3]; float s1 = 0.f, s2 = 0.f;
    bf16_t zca[3], zcb[3], zgc[3]; f32x4 w4[3][8]; float sv[3][30], gl[3], bl[3];
#pragma unroll
    for (int k = 0; k < 3; ++k) { const int c = ct + 256 * k; const unsigned vo = (unsigned)c * 4u;
        zca[k] = zr[zc_ca(c)]; zcb[k] = zr[zc_ca(c) + 128]; zgc[k] = zr[ZC_GC + c]; gl[k] = lg[c]; bl[k] = lb[c];
        const f32x4* wp = (const f32x4*)(cwt + (size_t)c * 32);
#pragma unroll
        for (int i = 0; i < 8; ++i) w4[k][i] = wp[i];
#pragma unroll
        for (int i = 0; i < 30; ++i) sv[k][i] = *(const float*)(stt + (size_t)i * 3072 + vo); }
    __builtin_amdgcn_sched_barrier(0);
#pragma unroll
    for (int k = 0; k < 3; ++k) { const int c = ct + 256 * k; const unsigned vo = (unsigned)c * 4u;
        const float un = bf1(zca[k]) * sigmoidf_(bf1(zcb[k]));
        float a = un * w4[k][7].z;
#pragma unroll
        for (int i = 0; i < 30; ++i) { a += sv[k][i] * w4[k][i >> 2][i & 3]; if (act && i >= 1) *(float*)(sco + (size_t)(i - 1) * 3072 + vo) = sv[k][i]; }
        if (act) *(float*)(sco + (size_t)29 * 3072 + vo) = un;
        cd[k] = a; s1 += a; s2 += a * a; }
    s1 = wave_sum(s1); s2 = wave_sum(s2);
    if (X.lane == 0) { red[X.wave * 2] = s1; red[X.wave * 2 + 1] = s2; }
    __syncthreads();
    const int w0 = half * 4;
    const float t1 = red[2 * w0] + red[2 * w0 + 2] + red[2 * w0 + 4] + red[2 * w0 + 6], t2 = red[2 * w0 + 1] + red[2 * w0 + 3] + red[2 * w0 + 5] + red[2 * w0 + 7];
    const float mean = t1 * (1.f / 768.f); const float var = fmaxf(t2 * (1.f / 768.f) - mean * mean, 0.f); const float rstd = 1.0f / sqrtf(var + LN_EPS);
    if (act) {
#pragma unroll
        for (int k = 0; k < 3; ++k) { const int c = ct + 256 * k;
            const float y = (cd[k] - mean) * rstd * gl[k] + bl[k];
            const float o = siluf_(y) * siluf_(bf1(zgc[k]));
            st_wt16(C2 + m * CW + c, (bf16_t)(cvt_pk_bf16(o, 0.f) & 0xffffu)); }
    }
    __syncthreads();
}

__device__ __forceinline__ void p2b_fix(Ctx& X) {
    const bf16_t* Z = (const bf16_t*)(X.ws + WS_Z); bf16_t* A2 = (bf16_t*)(X.ws + WS_A2); const float* LSE = (const float*)(X.ws + WS_LSE);
    const int NT = 32 * 512; const int ibase = X.xcc * (SEQ * 96), iend = ibase + SEQ * 96;
    for (int i0 = ibase + X.rank * 512 + X.tid; i0 < iend; i0 += 6 * NT) {
        u32x4 av[6], gv[6]; float l0[6], l1[6], l2[6];
#pragma unroll
        for (int u = 0; u < 6; ++u) { const int i = i0 + u * NT; const int ii = i < iend ? i : i0; const int m = ii / 96, q = ii - m * 96; const int hs = (q >> 3) & 3;
            av[u] = *(const u32x4*)(A2 + (size_t)m * AW + q * 8); gv[u] = __builtin_nontemporal_load((const u32x4*)(Z + (size_t)m * ZN + ZC_GA + q * 8));
            { const f32x4 L4 = *(const f32x4*)(LSE + ((size_t)m * 4 + hs) * 4); l0[u] = L4.x; l1[u] = L4.y; l2[u] = L4.z; } }
        __builtin_amdgcn_sched_barrier(0);
#pragma unroll
        for (int u = 0; u < 6; ++u) { const int i = i0 + u * NT; if (i < iend) { const int m = i / 96, q = i - m * 96; const int g = q >> 5;
            const float mx = fmaxf(l0[u], fmaxf(l1[u], l2[u]));
            const float e0 = __expf(l0[u] - mx), e1 = __expf(l1[u] - mx), e2 = __expf(l2[u] - mx);
            const float al = (g == 0 ? e0 : (g == 1 ? e1 : e2)) * __builtin_amdgcn_rcpf(e0 + e1 + e2);
            const u32x4 a = av[u], ga = gv[u]; u32x4 w;
            w.x = cvt_pk_bf16(bf_lo(a.x) * al * siluf_(bf_lo(ga.x)), bf_hi(a.x) * al * siluf_(bf_hi(ga.x))); w.y = cvt_pk_bf16(bf_lo(a.y) * al * siluf_(bf_lo(ga.y)), bf_hi(a.y) * al * siluf_(bf_hi(ga.y)));
            w.z = cvt_pk_bf16(bf_lo(a.z) * al * siluf_(bf_lo(ga.z)), bf_hi(a.z) * al * siluf_(bf_hi(ga.z))); w.w = cvt_pk_bf16(bf_lo(a.w) * al * siluf_(bf_lo(ga.w)), bf_hi(a.w) * al * siluf_(bf_hi(ga.w)));
            *(u32x4*)(A2 + (size_t)m * AW + q * 8) = w; } }
    }
}

__device__ __forceinline__ void p2_mix(Ctx& X, int layer) {
    const bf16_t* Z = (const bf16_t*)(X.ws + WS_Z); bf16_t* A2 = (bf16_t*)(X.ws + WS_A2); bf16_t* C2 = (bf16_t*)(X.ws + WS_C2); float* LSE = (float*)(X.ws + WS_LSE);
    constexpr int U_PA = 768, U_PC = 512;
    LAS unsigned char* wl = X.lds + X.wave * 12288;
    u32x4 pf[12]; const int cunit0 = X.xcc * (U_PC / 8) + X.rank;
    attn_prompt_wg(X, Z, A2, LSE, X.xcc, pf, cunit0);
    unsigned* xa = (unsigned*)(X.ws + WS_CTL) + CW_XA + 64 * X.xcc;
    asm volatile("s_waitcnt vmcnt(0)" ::: "memory");
    __syncthreads();
    if (X.tid == 0) xb_add(xa, 1u);
    conv_prompt_wg(X, Z, C2, layer, cunit0, pf);
    asm volatile("s_waitcnt vmcnt(0)" ::: "memory");
    __syncthreads();
    if (X.tid == 0) xb_add((unsigned*)(X.ws + WS_CTL) + CW_XC + 64 * X.xcc, 1u);
    if (X.tid == 0) { unsigned sp = 0; while (xb_ld(xa) < 32u * (unsigned)(layer + 1)) { __builtin_amdgcn_s_sleep(1); if (++sp > (1u << 22)) break; }
        __builtin_amdgcn_fence(__ATOMIC_ACQUIRE, "agent"); asm volatile("s_waitcnt vmcnt(0)" ::: "memory"); }
    __syncthreads();
    p2b_fix(X);
    asm volatile("s_waitcnt vmcnt(0)" ::: "memory");
    __syncthreads();
    if (X.tid == 0) xb_add((unsigned*)(X.ws + WS_CTL) + CW_XP + 64 * X.xcc, 1u);
}

template <bool WT>
__device__ __forceinline__ void p5_row(Ctx& X, int layer, int m) {
    const float* R = (const float*)(X.ws + WS_R); bf16_t* H = (bf16_t*)(X.ws + WS_H);
    const float* gpost = X.in[17] + (size_t)layer * 1024; const float* gpre = X.in[16] + (size_t)(layer + 1 < DEPTH ? layer + 1 : 0) * 1024;
    const float* xrow = (layer == 0) ? ((m < MP) ? X.in[0] + (size_t)m * 1024 : X.in[1] + (size_t)(m - MP) * 1024) : X.out + (size_t)m * 1024;
    float* yrow = X.out + (size_t)m * 1024;
    const f32x4* rr = (const f32x4*)(R + (size_t)m * 1024) + X.lane; const f32x4* xr = (const f32x4*)xrow + X.lane;
    f32x4 rv[4], xv[4], gp[4], gq[4]; float s = 0.f;
#pragma unroll
    for (int j = 0; j < 4; ++j) { rv[j] = rr[64 * j]; xv[j] = xr[64 * j]; gp[j] = ((const f32x4*)gpost)[X.lane + 64 * j]; gq[j] = ((const f32x4*)gpre)[X.lane + 64 * j]; }
    __builtin_amdgcn_sched_barrier(0);
#pragma unroll
    for (int j = 0; j < 4; ++j) s += (rv[j].x * rv[j].x + rv[j].y * rv[j].y) + (rv[j].z * rv[j].z + rv[j].w * rv[j].w);
    const float rs = 1.0f / sqrtf(wave_sum(s) * (1.f / 1024.f) + RMS_EPS);
    float s2 = 0.f;
#pragma unroll
    for (int j = 0; j < 4; ++j) { xv[j] = xv[j] + (rv[j] * rs) * gp[j]; if (WT) st16f_wt((f32x4*)yrow + X.lane + 64 * j, xv[j]); else ((f32x4*)yrow)[X.lane + 64 * j] = xv[j];
        s2 += (xv[j].x * xv[j].x + xv[j].y * xv[j].y) + (xv[j].z * xv[j].z + xv[j].w * xv[j].w); }
    if (layer + 1 < DEPTH) {
        const float rs2 = 1.0f / sqrtf(wave_sum(s2) * (1.f / 1024.f) + RMS_EPS);
        u32x2* o8 = (u32x2*)(H + (size_t)m * 1024) + X.lane;
#pragma unroll
        for (int j = 0; j < 4; ++j) { const f32x4 gg = gq[j]; u32x2 w; w.x = cvt_pk_bf16(xv[j].x * rs2 * gg.x, xv[j].y * rs2 * gg.y); w.y = cvt_pk_bf16(xv[j].z * rs2 * gg.z, xv[j].w * rs2 * gg.w); if (WT) st_wt64(o8 + 64 * j, w); else o8[64 * j] = w; }
    }
}

template <int K>
__device__ __forceinline__ f32x16 skinny_block(const bf16_t* A, int lda, const bf16_t* Bt, int lane) {
    const int r32 = lane & 31, hi = lane >> 5;
    const bf16_t* ap = A + (size_t)r32 * lda + hi * 8; const bf16_t* bp = Bt + (size_t)r32 * K + hi * 8;
    f32x16 acc = {};
    bf16x8 a0[8], b0[8], a1[8], b1[8];
#define SK_LOAD(a, b, k0) _Pragma("unroll") for (int j = 0; j < 8; ++j) { a[j] = *(const bf16x8*)(ap + (k0) + 16 * j); b[j] = *(const bf16x8*)(bp + (k0) + 16 * j); } __builtin_amdgcn_sched_barrier(0)
#define SK_MMA(a, b) _Pragma("unroll") for (int j = 0; j < 8; ++j) acc = __builtin_amdgcn_mfma_f32_32x32x16_bf16(a[j], b[j], acc, 0, 0, 0); __builtin_amdgcn_sched_barrier(0)
    SK_LOAD(a0, b0, 0);
#pragma unroll 1
    for (int k0 = 0; k0 < K; k0 += 256) {
        SK_LOAD(a1, b1, k0 + 128);
        SK_MMA(a0, b0);
        if (k0 + 256 < K) { SK_LOAD(a0, b0, k0 + 256); }
        SK_MMA(a1, b1);
    }
#undef SK_LOAD
#undef SK_MMA
    return acc;
}
__device__ __forceinline__ void svc_barrier(Ctx& X, unsigned target) {
    unsigned* ctr = (unsigned*)(X.ws + WS_CTL) + CW_SVC;
    asm volatile("s_waitcnt vmcnt(0)" ::: "memory");
    __syncthreads();
    if (X.tid == 0) {
        xb_add(ctr, 1u);
        unsigned sp = 0; while (xb_ld(ctr) < target) { __builtin_amdgcn_s_sleep(1); if (++sp > (1u << 22)) break; }
        __builtin_amdgcn_fence(__ATOMIC_ACQUIRE, "agent");
        asm volatile("s_waitcnt vmcnt(0)" ::: "memory");
    }
    __syncthreads();
}
__device__ __forceinline__ void svc_gemm1(Ctx& X, int layer, int sw) {
    const bf16_t* Hs = (const bf16_t*)(X.ws + WS_H) + (size_t)MP * 1024;
    const bf16_t* Wt = (const bf16_t*)(X.ws + WS_WIN + layer * SZ_WIN1);
    bf16_t* Z = (bf16_t*)(X.ws + WS_Z); const float* rope = (const float*)(X.ws + WS_ROPE) + 2048 * 16;
    const int r32 = X.lane & 31, hi = X.lane >> 5;
    for (int cb = sw; cb < ZN / 32; cb += NSVC * 8) {
        const f32x16 acc = skinny_block<1024>(Hs, 1024, Wt + (size_t)cb * 32 * 1024, X.lane);
        const int n = cb * 32 + r32, hc = n & 63;
        const bool ropeblk = (cb * 32 < 1536) && (((cb * 32) & 63) == 0);
        const float cs = rope[hc & 7], sn = rope[8 + (hc & 7)], sgn = (hc < 8) ? -1.f : 1.f;
        const float qs = (n < 768) ? QSCALE : 1.f;
        float* st = nullptr; int Wg = 0;
        if (n >= 768 && n < 2304) { const bool isv = n >= 1536; const int nn = n - (isv ? 1536 : 768); const int g = nn >> 8; Wg = 128 << (2 * g);
            const size_t base = isv ? (g == 0 ? O_SV0 : g == 1 ? O_SV1 : O_SV2) : (g == 0 ? O_SK0 : g == 1 ? O_SK1 : O_SK2); st = X.out + base + (size_t)(Wg - 1) * 256 + (nn & 255); }
#pragma unroll
        for (int r = 0; r < 16; ++r) { const int m = crow(r, hi); float v = acc[r];
            if (ropeblk) { const float p = __shfl_xor(v, 8); if (hc < 16) v = v * cs + sgn * p * sn; }
            v *= qs;
            st_wt16(Z + ((size_t)MP + m) * ZN + n, (bf16_t)(cvt_pk_bf16(v, 0.f) & 0xffffu));
            if (st) st[(size_t)(layer * 32 + m) * Wg * 256] = v; }
    }
}
template <int K, int KS>
__device__ __forceinline__ void skinny_part2(const bf16_t* A, int lda, const bf16_t* Bt0, const bf16_t* Bt1, int wave, int lane, f32x16& acc0, f32x16& acc1) {
    const int r32 = lane & 31, hi = lane >> 5;
    const bf16_t* ap = A + (size_t)r32 * lda + wave * KS + hi * 8; const bf16_t* bp0 = Bt0 + (size_t)r32 * K + wave * KS + hi * 8; const bf16_t* bp1 = Bt1 + (size_t)r32 * K + wave * KS + hi * 8;
    bf16x8 a[KS / 16], b0[KS / 16], b1[KS / 16];
#pragma unroll
    for (int j = 0; j < KS / 16; ++j) { a[j] = *(const bf16x8*)(ap + 16 * j); b0[j] = *(const bf16x8*)(bp0 + 16 * j); b1[j] = *(const bf16x8*)(bp1 + 16 * j); }
    __builtin_amdgcn_sched_barrier(0);
#pragma unroll
    for (int j = 0; j < KS / 16; ++j) { acc0 = __builtin_amdgcn_mfma_f32_32x32x16_bf16(a[j], b0[j], acc0, 0, 0, 0); acc1 = __builtin_amdgcn_mfma_f32_32x32x16_bf16(a[j], b1[j], acc1, 0, 0, 0); }
}
__device__ __forceinline__ void svc_gemm2(Ctx& X, int layer, int sv) {
    const bf16_t* Z = (const bf16_t*)(X.ws + WS_Z); bf16_t* MG = (bf16_t*)(X.ws + WS_MG);
    const int r32 = X.lane & 31, hi = X.lane >> 5;
    LAS float* red = (LAS float*)X.lds;
    const int cb0 = sv, cb1 = (sv + NSVC < 32) ? sv + NSVC : sv;
    const bf16_t* Wao = (const bf16_t*)(X.ws + WS_WAO + layer * SZ_WAO1); const bf16_t* Wco = (const bf16_t*)(X.ws + WS_WCO + layer * SZ_WAO1);
    f32x16 ya0 = {}, ya1 = {}, yc0 = {}, yc1 = {};
    bf16_t gma[2][2], gmc[2][2];
#pragma unroll
    for (int q = 0; q < 2; ++q) { const size_t m = (size_t)MP + crow(2 * X.wave + q, hi);
        gma[q][0] = Z[m * ZN + ZC_MA + cb0 * 32 + r32]; gmc[q][0] = Z[m * ZN + ZC_MC + cb0 * 32 + r32]; gma[q][1] = Z[m * ZN + ZC_MA + cb1 * 32 + r32]; gmc[q][1] = Z[m * ZN + ZC_MC + cb1 * 32 + r32]; }
    skinny_part2<768, 96>((const bf16_t*)(X.ws + WS_A2) + (size_t)MP * 768, 768, Wao + (size_t)cb0 * 32 * 768, Wao + (size_t)cb1 * 32 * 768, X.wave, X.lane, ya0, ya1);
    skinny_part2<768, 96>((const bf16_t*)(X.ws + WS_C2) + (size_t)MP * 768, 768, Wco + (size_t)cb0 * 32 * 768, Wco + (size_t)cb1 * 32 * 768, X.wave, X.lane, yc0, yc1);
#pragma unroll
    for (int r = 0; r < 16; ++r) { red[((0 * 8 + X.wave) * 16 + r) * 64 + X.lane] = ya0[r]; red[((1 * 8 + X.wave) * 16 + r) * 64 + X.lane] = yc0[r];
                                   red[((2 * 8 + X.wave) * 16 + r) * 64 + X.lane] = ya1[r]; red[((3 * 8 + X.wave) * 16 + r) * 64 + X.lane] = yc1[r]; }
    __syncthreads();
#pragma unroll
    for (int q = 0; q < 2; ++q) { const int r = 2 * X.wave + q; float sa0 = 0.f, sc0 = 0.f, sa1 = 0.f, sc1 = 0.f;
#pragma unroll
        for (int w = 0; w < 8; ++w) { sa0 += red[((0 * 8 + w) * 16 + r) * 64 + X.lane]; sc0 += red[((1 * 8 + w) * 16 + r) * 64 + X.lane]; sa1 += red[((2 * 8 + w) * 16 + r) * 64 + X.lane]; sc1 += red[((3 * 8 + w) * 16 + r) * 64 + X.lane]; }
        const size_t m = (size_t)MP + crow(r, hi);
        const float v0 = sigmoidf_(bf1(gma[q][0])) * sa0 + sigmoidf_(bf1(gmc[q][0])) * sc0, v1 = sigmoidf_(bf1(gma[q][1])) * sa1 + sigmoidf_(bf1(gmc[q][1])) * sc1;
        st_wt16(MG + m * 1024 + cb0 * 32 + r32, (bf16_t)(cvt_pk_bf16(v0, 0.f) & 0xffffu));
        if (cb1 != cb0) st_wt16(MG + m * 1024 + cb1 * 32 + r32, (bf16_t)(cvt_pk_bf16(v1, 0.f) & 0xffffu)); }
    __syncthreads();
}
__device__ __forceinline__ void svc_gemm3(Ctx& X, int layer, int sv) {
    float* R = (float*)(X.ws + WS_R);
    const int r32 = X.lane & 31, hi = X.lane >> 5;
    LAS float* red = (LAS float*)X.lds;
    const int cb0 = sv, cb1 = (sv + NSVC < 32) ? sv + NSVC : sv;
    const bf16_t* Wo = (const bf16_t*)(X.ws + WS_WO + layer * SZ_WO1);
    f32x16 r0 = {}, r1 = {};
    skinny_part2<1024, 128>((const bf16_t*)(X.ws + WS_MG) + (size_t)MP * 1024, 1024, Wo + (size_t)cb0 * 32 * 1024, Wo + (size_t)cb1 * 32 * 1024, X.wave, X.lane, r0, r1);
#pragma unroll
    for (int r = 0; r < 16; ++r) { red[((0 * 8 + X.wave) * 16 + r) * 64 + X.lane] = r0[r]; red[((1 * 8 + X.wave) * 16 + r) * 64 + X.lane] = r1[r]; }
    __syncthreads();
#pragma unroll
    for (int q = 0; q < 2; ++q) { const int r = 2 * X.wave + q; float s0 = 0.f, s1 = 0.f;
#pragma unroll
        for (int w = 0; w < 8; ++w) { s0 += red[((0 * 8 + w) * 16 + r) * 64 + X.lane]; s1 += red[((1 * 8 + w) * 16 + r) * 64 + X.lane]; }
        st_wt32(R + ((size_t)MP + crow(r, hi)) * 1024 + cb0 * 32 + r32, s0);
        if (cb1 != cb0) st_wt32(R + ((size_t)MP + crow(r, hi)) * 1024 + cb1 * 32 + r32, s1); }
    __syncthreads();
}
__device__ __forceinline__ void service_layer(Ctx& X, int layer) {
    const int sv = X.vb - NG1, sw = sv * 8 + X.wave;
    const unsigned e0 = (unsigned)layer * 5u * NSVC;
    const bf16_t* Z = (const bf16_t*)(X.ws + WS_Z); bf16_t* A2 = (bf16_t*)(X.ws + WS_A2); bf16_t* C2 = (bf16_t*)(X.ws + WS_C2);
    svc_gemm1(X, layer, sw);
    svc_barrier(X, e0 + 1u * NSVC);
    if (sw < 128) attn_sample_unit3(Z, X.in, A2, layer, sw, X.lds + X.wave * 12288, X.lane);
    __syncthreads();
    conv_sample_pair(X, Z, C2, layer, sv);
    svc_barrier(X, e0 + 2u * NSVC);
    svc_gemm2(X, layer, sv);
    svc_barrier(X, e0 + 3u * NSVC);
    svc_gemm3(X, layer, sv);
    svc_barrier(X, e0 + 4u * NSVC);
    if (sw < DEC_BATCH) p5_row<true>(X, layer, MP + sw);
    svc_barrier(X, e0 + 5u * NSVC);
}

constexpr int N_PHASES = 1 + 4 * DEPTH;
__global__ void __launch_bounds__(NWAVES * 64, 2) hybrid_fwd(Args args) {
    extern __shared__ __attribute__((aligned(16))) unsigned char lds_raw[];
    Ctx X;
    X.lds = (LAS unsigned char*)lds_raw;
    X.tid = threadIdx.x; X.lane = X.tid & 63; X.wave = __builtin_amdgcn_readfirstlane(X.tid >> 6);
    X.G = gridDim.x;
    X.in = args.in; X.out = args.out; X.ws = args.ws;
    volatile LAS unsigned* MISC = (volatile LAS unsigned*)(X.lds + MISC_OFF);
    for (int u = X.tid; u < (LDS_BYTES - LDSCTL_OFF) / 4; u += NWAVES * 64) ((LAS unsigned*)(X.lds + LDSCTL_OFF))[u] = 0u;
    __syncthreads();
    {
        const unsigned x = xb_xcc_id() & 7u;
        if (X.tid == 0) MISC[16] = xb_add((unsigned*)(X.ws + WS_CTL) + CW_RANK + 64 * x, 1u) & 31u;
        __syncthreads();
        X.xcc = (int)x; X.rank = __builtin_amdgcn_readfirstlane((int)MISC[16]); X.vb = X.rank * 8 + X.xcc; X.vcu = X.xcc * 32 + X.rank;
    }
    const int xcc0 = X.xcc, rank0 = X.rank;
    unsigned* barw = (unsigned*)(X.ws + WS_CTL) + CW_BAR;
    XcdBarrier bar; bar.bar = barw; bar.x = 0; bar.st = nullptr;
    bar = xcd_barrier_post(barw, MISC + 8);
    const int wave0 = X.wave;

    unsigned nxl = 0;
    for (int ph = 0; ph < N_PHASES; ++ph) {
        { GAS unsigned char* w_ = (GAS unsigned char*)args.ws; GAS float* o_ = (GAS float*)args.out; asm volatile("" : "+s"(w_), "+s"(o_)); X.ws = (unsigned char*)w_; X.out = (float*)o_;
          int wv_ = wave0, ln_; asm volatile("" : "+s"(wv_)); asm volatile("v_mbcnt_lo_u32_b32 %0, -1, 0\n\tv_mbcnt_hi_u32_b32 %0, -1, %0" : "=v"(ln_));
          X.tid = wv_ * 64 + ln_; X.lane = ln_; X.wave = wv_;
          int x_ = xcc0, r_ = rank0; asm volatile("" : "+s"(x_), "+s"(r_)); X.xcc = x_; X.rank = r_; X.vb = r_ * 8 + x_; X.vcu = x_ * 32 + r_; }
        if (ph == 0) { p0_prep(X); }
        else {
            const int layer = (ph - 1) / 4, sub = (ph - 1) % 4;
            if (sub == 0) {
                if (X.vb < NG1) {
                    pg8::Sched S; S.init(MP, ZN, 1024, NG1, X.vb, 1, X.ws + WS_H, X.ws + WS_WIN + layer * SZ_WIN1, nullptr, nullptr); S.wgm = 4; S.rev = true;
                    Epi1 E{(bf16_t*)(X.ws + WS_Z), (const float*)(X.ws + WS_ROPE), X.out, layer, X.in, layer * 6, X.vb};
                    pg8::gemm_phase<Epi1, true>(X.lds, 1024, S, E, X.tid);
                } else {
                    service_layer(X, layer);
                }
            } else if (sub == 1) {
                p2_mix(X, layer);
            } else if (sub == 2) {
                pg8::Sched S; S.init(MP, 1024, 768, X.G, X.vb, 2, X.ws + WS_C2, X.ws + WS_WCO + layer * SZ_WAO1, X.ws + WS_A2, X.ws + WS_WAO + layer * SZ_WAO1);
                Epi2 E{(const bf16_t*)(X.ws + WS_Z), (bf16_t*)(X.ws + WS_MG), (unsigned*)(X.ws + WS_CTL) + CW_XC + 64 * X.xcc, (unsigned*)(X.ws + WS_CTL) + CW_XP + 64 * X.xcc, 32u * (unsigned)(layer + 1)};
                pg8::gemm_phase<Epi2, true>(X.lds, 768, S, E, X.tid);
                if (X.tid == 0) xb_add((unsigned*)(X.ws + WS_CTL) + CW_PAN1 + 64 * (8 * X.xcc + (X.rank & 7)), 1u);
            } else if (sub == 3) {
                pg8::Sched S; S.init(MP, 1024, 1024, X.G, X.vb, 1, X.ws + WS_MG, X.ws + WS_WO + layer * SZ_WO1, nullptr, nullptr);
                Epi3F<false> E{X.in[0], X.out, (bf16_t*)(X.ws + WS_H), X.in[17] + (size_t)layer * 1024, X.in[16] + (size_t)(layer + 1 < DEPTH ? layer + 1 : 0) * 1024,
                    (float*)(X.ws + WS_XB1), (float*)(X.ws + WS_XB2), (unsigned*)(X.ws + WS_CTL) + CW_PAN1, (unsigned*)(X.ws + WS_CTL) + CW_PAN2, 4u * (unsigned)(layer + 1), layer + 1 == DEPTH, X.in[16] + (size_t)layer * 1024, (float*)(X.ws + WS_RS)};
                pg8::gemm_phase<Epi3F<false>, false>(X.lds, 1024, S, E, X.tid);
            }
        }
        if (ph + 1 < N_PHASES) {
            if (ph == 0) xcd_barrier(bar);
            else if ((ph - 1) % 4 == 0 || (ph - 1) % 4 == 3) { ++nxl; xl_barrier((unsigned*)(X.ws + WS_CTL) + CW_XL + 64 * X.xcc, 32u * nxl); }
        }
    }
}

extern "C" void kernel_launch(void* const* d_in, const int* in_sizes, int n_in, void* d_out, int out_size, void* d_ws, size_t ws_size, hipStream_t stream) {
    static int grid = 0;
    if (grid == 0) {
        if (n_in != 18 || (size_t)out_size != O_END || ws_size < WS_END) { fprintf(stderr, "kernel_launch: unexpected shapes: n_in %d out %d ws %zu (need %zu)\n", n_in, out_size, ws_size, (size_t)WS_END); grid = -1; return; }
        int dev = 0, cus = 0;
        if (hipGetDevice(&dev) != hipSuccess || hipDeviceGetAttribute(&cus, hipDeviceAttributeMultiprocessorCount, dev) != hipSuccess) { grid = -1; return; }
        if (hipFuncSetAttribute((const void*)hybrid_fwd, hipFuncAttributeMaxDynamicSharedMemorySize, LDS_BYTES) != hipSuccess) { fprintf(stderr, "kernel_launch: hipFuncSetAttribute failed\n"); grid = -1; return; }
        int per_cu = 0;
        if (hipOccupancyMaxActiveBlocksPerMultiprocessor(&per_cu, (const void*)hybrid_fwd, NWAVES * 64, LDS_BYTES) != hipSuccess || per_cu < 1) fprintf(stderr, "kernel_launch: occupancy query reports %d\n", per_cu);
        (void)hipGetLastError();
        grid = cus;
        if (grid != NG1 + NSVC) { fprintf(stderr, "kernel_launch: built for %d CUs, device has %d\n", NG1 + NSVC, cus); grid = -1; return; }
    }
    if (grid < 0) return;
    (void)hipMemsetAsync((char*)d_ws + WS_CTL, 0, CTL_ZERO_BYTES, stream);
    Args a{};
    for (int i = 0; i < 18; ++i) a.in[i] = (const float*)d_in[i];
    a.out = (float*)d_out; a.ws = (unsigned char*)d_ws;
    a.ph_lo = 0; a.ph_hi = N_PHASES; a.li = 0;
    hipLaunchKernelGGL(hybrid_fwd, dim3(grid), dim3(NWAVES * 64), LDS_BYTES, stream, a);
}
```

```cpp
#include <hip/hip_runtime.h>
#include <cstdio>
#include <cstdint>

#ifndef MK_N_LAUNCHES
#define MK_N_LAUNCHES 1
#endif

#define LAS __attribute__((address_space(3)))
#define GAS __attribute__((address_space(1)))
typedef unsigned short bf16_t;
typedef short bf16x8 __attribute__((ext_vector_type(8)));
typedef short s16x4 __attribute__((ext_vector_type(4)));
typedef float f32x4 __attribute__((ext_vector_type(4)));
typedef float f32x2 __attribute__((ext_vector_type(2)));
typedef float f32x16 __attribute__((ext_vector_type(16)));
typedef unsigned u32x4 __attribute__((ext_vector_type(4)));
typedef unsigned u32x2 __attribute__((ext_vector_type(2)));

constexpr int D_MODEL = 1024, BATCH = 8, SEQ = 2048, DEPTH = 4, DEC_BATCH = 32;
constexpr int MP = BATCH * SEQ;
constexpr int MR = MP + DEC_BATCH;
constexpr int MPAD = 16640;
constexpr int ZN = 7424;
constexpr int ZC_Q = 0, ZC_K = 768, ZC_V = 1536, ZC_GA = 2304, ZC_CA = 3072, ZC_CB = 3840, ZC_GC = 4608, ZC_MA = 5376, ZC_MC = 6400;
constexpr int AW = 768, CW = 768, CONV_K = 31;
__host__ __device__ __forceinline__ constexpr int zc_ca(int c) { return 3072 + 256 * (c >> 7) + (c & 127); }
constexpr float RMS_EPS = 1e-6f, LN_EPS = 1e-5f;
constexpr float LOG2E = 1.4426950408889634f, LN2 = 0.6931471805599453f;
constexpr float QSCALE = 0.125f * LOG2E;

constexpr size_t O_YP = 0;
constexpr size_t O_YS = O_YP + (size_t)MP * D_MODEL;
constexpr size_t O_PK0 = O_YS + (size_t)DEC_BATCH * D_MODEL;
constexpr size_t SZ_P0 = (size_t)DEPTH * BATCH * 128 * 256, SZ_P1 = (size_t)DEPTH * BATCH * 512 * 256, SZ_P2 = (size_t)DEPTH * BATCH * 2048 * 256;
constexpr size_t O_PV0 = O_PK0 + SZ_P0, O_PK1 = O_PV0 + SZ_P0, O_PV1 = O_PK1 + SZ_P1, O_PK2 = O_PV1 + SZ_P1, O_PV2 = O_PK2 + SZ_P2;
constexpr size_t O_PC = O_PV2 + SZ_P2;
constexpr size_t SZ_PC = (size_t)DEPTH * BATCH * 30 * 768;
constexpr size_t O_SK0 = O_PC + SZ_PC;
constexpr size_t SZ_S0 = (size_t)DEPTH * DEC_BATCH * 128 * 256, SZ_S1 = (size_t)DEPTH * DEC_BATCH * 512 * 256, SZ_S2 = (size_t)DEPTH * DEC_BATCH * 2048 * 256;
constexpr size_t O_SV0 = O_SK0 + SZ_S0, O_SK1 = O_SV0 + SZ_S0, O_SV1 = O_SK1 + SZ_S1, O_SK2 = O_SV1 + SZ_S1, O_SV2 = O_SK2 + SZ_S2;
constexpr size_t O_SC = O_SV2 + SZ_S2;
constexpr size_t SZ_SC = (size_t)DEPTH * DEC_BATCH * 30 * 768;
constexpr size_t O_END = O_SC + SZ_SC;
static_assert(O_END == 240697344ull, "output size");

constexpr size_t MiB = 1u << 20;
constexpr size_t WS_CTL = 0, CTL_ZERO_BYTES = 2 * MiB;
constexpr size_t WS_XB1 = 1 * MiB;
constexpr size_t WS_XB2 = WS_XB1 + (size_t)16384 * 4 * 8;
constexpr size_t WS_ROPE = 2 * MiB;
constexpr size_t WS_WIN = 3 * MiB;
constexpr size_t SZ_WIN1 = (size_t)ZN * 1024 * 2;
constexpr size_t WS_WAO = WS_WIN + 4 * SZ_WIN1;
constexpr size_t SZ_WAO1 = (size_t)1024 * 768 * 2;
constexpr size_t WS_WCO = WS_WAO + 4 * SZ_WAO1;
constexpr size_t WS_WO = WS_WCO + 4 * SZ_WAO1;
constexpr size_t SZ_WO1 = (size_t)1024 * 1024 * 2;
constexpr size_t WS_H = WS_WO + 4 * SZ_WO1;
constexpr size_t WS_Z = WS_H + (size_t)MPAD * 1024 * 2;
constexpr size_t WS_A2 = WS_Z + (size_t)MPAD * ZN * 2;
constexpr size_t WS_C2 = WS_A2 + (size_t)MPAD * 768 * 2;
constexpr size_t WS_MG = WS_C2 + (size_t)MPAD * 768 * 2;
constexpr size_t WS_R = WS_MG + (size_t)MPAD * 1024 * 2;
constexpr size_t WS_LSE = WS_R + (size_t)MPAD * 1024 * 4;
constexpr size_t WS_CWT = WS_LSE + (size_t)MPAD * 16 * 4;
constexpr size_t WS_RS = WS_CWT + (size_t)4 * 768 * 32 * 4;
constexpr size_t WS_END = WS_RS + (size_t)MP * 4;

constexpr int CW_BAR = 4096;
constexpr int CW_SVC = 8192;
constexpr int CW_RANK = 9216;
constexpr int CW_XL = 9728;
constexpr int CW_XC = 19456, CW_XP = 19968;
constexpr int CW_XA = 18432;
constexpr int CW_PAN1 = 10240, CW_PAN2 = 14336;
constexpr int NSVC = 24, NG1 = 232;

constexpr int RING_BYTES = 131072;
constexpr int LDSCTL_OFF = 150528;
constexpr int MISC_OFF = LDSCTL_OFF + 320;
constexpr int LDS_BYTES = LDSCTL_OFF + 1024;
constexpr int NWAVES = 8;

#define RLX_AGENT __ATOMIC_RELAXED, __HIP_MEMORY_SCOPE_AGENT
#define LDS_WAIT() asm volatile("s_waitcnt lgkmcnt(0)" ::: "memory")
#define VM_WAIT() asm volatile("s_waitcnt vmcnt(0)" ::: "memory")

__device__ __forceinline__ unsigned cvt_pk_bf16(float lo, float hi) { unsigned r; asm volatile("v_cvt_pk_bf16_f32 %0, %1, %2" : "=v"(r) : "v"(lo), "v"(hi)); return r; }
__device__ __forceinline__ void st_wt16(bf16_t* p, bf16_t v) { __hip_atomic_store(p, v, __ATOMIC_RELAXED, __HIP_MEMORY_SCOPE_AGENT); }
__device__ __forceinline__ void st_wt32(float* p, float v) { __hip_atomic_store((unsigned*)p, __float_as_uint(v), __ATOMIC_RELAXED, __HIP_MEMORY_SCOPE_AGENT); }
__device__ __forceinline__ void st_wt64(void* p, u32x2 v) { __hip_atomic_store((unsigned long long*)p, ((unsigned long long)v.y << 32) | v.x, __ATOMIC_RELAXED, __HIP_MEMORY_SCOPE_AGENT); }
__device__ __forceinline__ void st16f_wt(void* p, f32x4 v) { asm volatile("global_store_dwordx4 %0, %1, off sc1\n\ts_nop 1" :: "v"((GAS void*)p), "v"(v) : "memory"); }
__device__ __forceinline__ float bf_lo(unsigned u) { return __uint_as_float(u << 16); }
__device__ __forceinline__ float bf_hi(unsigned u) { return __uint_as_float(u & 0xffff0000u); }
__device__ __forceinline__ float bf1(bf16_t u) { return __uint_as_float(((unsigned)u) << 16); }
__device__ __forceinline__ float sigmoidf_(float x) { return __builtin_amdgcn_rcpf(1.0f + __expf(-x)); }
__device__ __forceinline__ float siluf_(float x) { return x * __builtin_amdgcn_rcpf(1.0f + __expf(-x)); }
__device__ __forceinline__ float wave_sum(float v) {
#pragma unroll
    for (int o = 1; o < 64; o <<= 1) v += __shfl_xor(v, o);
    return v;
}
__device__ __forceinline__ float wave_max(float v) {
#pragma unroll
    for (int o = 1; o < 64; o <<= 1) v = fmaxf(v, __shfl_xor(v, o));
    return v;
}

namespace pg8 {
constexpr int BM = 256, BK = 64, HALF = 128, HTB = HALF * BK * 2, STAGE_BYTES = 8 * HTB, NXCD = 8, WGM = 8;
__host__ __device__ __forceinline__ int lds_byte(int r, int c) { const int st = (r >> 4) * 2 + (c >> 5), rr = r & 15, cc = c & 31, ob = rr * 64 + cc * 2; return st * 1024 + (ob ^ (((ob >> 9) & 1) << 5)); }
__host__ __device__ __forceinline__ void stage_rc(int b, int& R, int& C) { const int st = b / 1024, sb = b % 1024, swz = sb ^ (((sb >> 9) & 1) << 5); R = (st >> 1) * 16 + swz / 64; C = (st & 1) * 32 + (swz % 64) / 2; }
__host__ __device__ __forceinline__ int perm32(int rho) { const int n = rho >> 4, i = rho & 15; return 8 * (i >> 2) + 4 * n + (i & 3); }

struct Unit { int pm, pn, which; };

struct Sched {
    int nM, nN, nwg, G, c, NW, wgm = WGM; bool rev = false;
    const char* A[2]; const char* B[2]; size_t tstep;
    __device__ void init(int M, int N, int K, int G_, int c_, int NW_, const void* A0, const void* B0, const void* A1, const void* B1) {
        nM = M / BM; nN = N / BM; nwg = nM * nN; G = G_; c = c_; NW = NW_; A[0] = (const char*)A0; A[1] = (const char*)A1; B[0] = (const char*)B0; B[1] = (const char*)B1; tstep = (size_t)BM * K * 2; }
    __device__ bool next(int i, Unit& u) const {
        const int it = (NW == 2) ? (i >> 1) : i;
        const long L = (long)it * G + c; if (L >= nwg) return false;
        int wgid = (int)L; { const int q = nwg / NXCD, r = nwg % NXCD, xcd = wgid % NXCD, off = wgid / NXCD; wgid = (xcd < r ? xcd * (q + 1) : r * (q + 1) + (xcd - r) * q) + off; }
        const int nig = wgm * nN, gid = wgid / nig, fm = gid * wgm, gsz = (nM - fm) < wgm ? (nM - fm) : wgm;
        u.pm = fm + ((wgid % nig) % gsz); u.pn = (wgid % nig) / gsz; if (rev) u.pn = nN - 1 - u.pn; u.which = (NW == 2) ? (i & 1) : 0; return true;
    }
    __device__ __forceinline__ const char* abase(const Unit& u) const { return (u.which ? A[1] : A[0]) + (size_t)u.pm * tstep; }
    __device__ __forceinline__ const char* bbase(const Unit& u) const { return (u.which ? B[1] : B[0]) + (size_t)u.pn * tstep; }
};

template <class Epi, bool ALIGN_EPI = true>
__device__ __forceinline__ void gemm_phase(LAS unsigned char* lds, const int K, const Sched& S, const Epi& E, const int tid) {
    const int wid = __builtin_amdgcn_readfirstlane(tid >> 6), lane = tid & 63, wr = wid >> 2, wc = wid & 3, fr = lane & 15, fq = lane >> 4;
    const int nt = K / BK;
    unsigned voffA[2], voffB[2];
#pragma unroll
    for (int i = 0; i < 2; ++i) { int R, C; stage_rc(tid * 16 + i * 8192, R, C); const int Rb = Epi::PERM ? ((R & ~31) + perm32(R & 31)) : R;
        voffA[i] = (unsigned)(R * K + C) * 2u; voffB[i] = (unsigned)(Rb * K + C) * 2u; }
    const size_t kstep = (size_t)(BK * 2);
    const size_t hstep = (size_t)HALF * K * 2;
    const unsigned ldsw = (unsigned)wid * 1024u;
    const int aoff = lds_byte(wr * 64 + fr, fq * 8), boff = lds_byte(wc * 32 + fr, fq * 8);
#define PG8_SA(b, h) (((b) * 2 + (h)) * HTB)
#define PG8_SB(b, h) ((4 + (b) * 2 + (h)) * HTB)
#define PG8_STAGE(bufoff, gbase, voff) do { _Pragma("unroll") for (int _i = 0; _i < 2; ++_i) \
        __builtin_amdgcn_global_load_lds((const unsigned*)((const char*)(gbase) + (voff)[_i]), (LAS unsigned*)(lds + (bufoff) + ldsw + _i * 8192), 16, 0, 0); } while (0)
#define PG8_STAGEB(bufoff, gbase, voff) do { _Pragma("unroll") for (int _i = 0; _i < 2; ++_i) \
        __builtin_amdgcn_global_load_lds((const unsigned*)((const char*)(gbase) + (voff)[_i]), (LAS unsigned*)(lds + (bufoff) + ldsw + _i * 8192), 16, 0, Epi::B_NT ? 2 : 0); } while (0)
#define PG8_LDA(dst, b, h) do { _Pragma("unroll") for (int m = 0; m < 4; ++m) _Pragma("unroll") for (int k = 0; k < 2; ++k) dst[m][k] = *(const LAS bf16x8*)(lds + PG8_SA(b, h) + aoff + m * 2048 + k * 1024); } while (0)
#define PG8_LDB(dst, b, h) do { _Pragma("unroll") for (int n = 0; n < 2; ++n) _Pragma("unroll") for (int k = 0; k < 2; ++k) dst[n][k] = *(const LAS bf16x8*)(lds + PG8_SB(b, h) + boff + n * 2048 + k * 1024); } while (0)
#define PG8_MMA(ai, bj, At, Bt) do { __builtin_amdgcn_s_setprio(1); _Pragma("unroll") for (int m = 0; m < 4; ++m) _Pragma("unroll") for (int n = 0; n < 2; ++n) _Pragma("unroll") for (int k = 0; k < 2; ++k) \
        acc[ai][bj][m][n] = __builtin_amdgcn_mfma_f32_16x16x32_bf16(Bt[n][k], At[m][k], acc[ai][bj][m][n], 0, 0, 0); __builtin_amdgcn_s_setprio(0); } while (0)
#define PG8_WAIT_V(n) asm volatile("s_waitcnt vmcnt(" #n ")" ::: "memory")
#define PG8_WAIT_L(n) asm volatile("s_waitcnt lgkmcnt(" #n ")" ::: "memory")
#define PG8_BAR __builtin_amdgcn_s_barrier()
#define PG8_SCHED __builtin_amdgcn_sched_barrier(0)
    Unit cur, nxt; int ui = 0;
    if (!S.next(0, cur)) return;
    f32x4 acc[2][2][4][2];
#pragma unroll
    for (int a = 0; a < 2; ++a)
#pragma unroll
        for (int b = 0; b < 2; ++b)
#pragma unroll
            for (int m = 0; m < 4; ++m)
#pragma unroll
                for (int n = 0; n < 2; ++n) acc[a][b][m][n] = (f32x4){0.f, 0.f, 0.f, 0.f};
    bf16x8 At[4][2], B0[2][2], B1[2][2];
    const char* cA = S.abase(cur); const char* cB = S.bbase(cur);
    PG8_STAGEB(PG8_SB(0, 0), cB, voffB); PG8_STAGEB(PG8_SB(0, 1), cB + hstep, voffB);
    if constexpr (Epi::WAIT_A) E.pre_a(cur, tid);
    PG8_STAGE(PG8_SA(0, 0), cA, voffA); PG8_STAGE(PG8_SA(0, 1), cA + hstep, voffA);
    if (wr == 1) PG8_BAR;
    PG8_WAIT_V(2); PG8_BAR;
    PG8_STAGEB(PG8_SB(1, 0), cB + kstep, voffB); PG8_STAGE(PG8_SA(1, 0), cA + kstep, voffA); PG8_STAGEB(PG8_SB(1, 1), cB + hstep + kstep, voffB);
    PG8_WAIT_V(6); PG8_BAR;
    for (;;) {
        const bool has_next = S.next(ui + 1, nxt);
        const char* nA = has_next ? S.abase(nxt) : cA; const char* nB = has_next ? S.bbase(nxt) : cB;
        for (int t = 0; t < nt; t += 2) {
            if constexpr (Epi::WAIT_MID) { if (t == nt - 4 && cur.which == 0) E.mid_wait(tid); }
            const bool last = (t == nt - 2);
            const char* a1 = cA + (size_t)(t + 1) * kstep;
            const char* a2 = last ? nA : cA + (size_t)(t + 2) * kstep; const char* b2 = last ? nB : cB + (size_t)(t + 2) * kstep;
            const char* a3 = a2 + kstep; const char* b3 = b2 + kstep;
            PG8_LDB(B0, 0, 0); PG8_LDB(B1, 0, 1); PG8_SCHED; PG8_LDA(At, 0, 0); PG8_STAGE(PG8_SA(1, 1), a1 + hstep, voffA);
            PG8_WAIT_V(8); PG8_WAIT_L(0); PG8_BAR; PG8_MMA(0, 0, At, B0); PG8_MMA(0, 1, At, B1); PG8_BAR; PG8_SCHED;
            PG8_LDA(At, 0, 1); PG8_STAGEB(PG8_SB(0, 0), b2, voffB); PG8_STAGEB(PG8_SB(0, 1), b2 + hstep, voffB); PG8_STAGE(PG8_SA(0, 0), a2, voffA);
            PG8_WAIT_V(8); PG8_WAIT_L(0); PG8_BAR; PG8_MMA(1, 0, At, B0); PG8_MMA(1, 1, At, B1); PG8_BAR; PG8_SCHED;
            PG8_LDB(B0, 1, 0); PG8_LDB(B1, 1, 1); PG8_SCHED; PG8_LDA(At, 1, 0); PG8_STAGE(PG8_SA(0, 1), a2 + hstep, voffA);
            PG8_WAIT_V(8); PG8_WAIT_L(0); PG8_BAR; PG8_MMA(0, 0, At, B0); PG8_MMA(0, 1, At, B1); PG8_BAR; PG8_SCHED;
            PG8_LDA(At, 1, 1); PG8_STAGEB(PG8_SB(1, 0), b3, voffB); PG8_STAGEB(PG8_SB(1, 1), b3 + hstep, voffB); PG8_STAGE(PG8_SA(1, 0), a3, voffA);
            PG8_WAIT_V(8); PG8_WAIT_L(0); PG8_BAR; PG8_MMA(1, 0, At, B0); PG8_MMA(1, 1, At, B1); PG8_BAR; PG8_SCHED;
        }
        if constexpr (ALIGN_EPI) { if (wr == 0) PG8_BAR; }
        if constexpr (!Epi::AFTER_DRAIN) E(acc, cur, wr, wc, fr, fq, ui);
        if (!has_next) break;
        if (!Epi::keep_acc(cur)) {
#pragma unroll
        for (int a = 0; a < 2; ++a)
#pragma unroll
            for (int b = 0; b < 2; ++b)
#pragma unroll
                for (int m = 0; m < 4; ++m)
#pragma unroll
                    for (int n = 0; n < 2; ++n) acc[a][b][m][n] = (f32x4){0.f, 0.f, 0.f, 0.f};
        }
        cur = nxt; cA = nA; cB = nB; ++ui;
        if constexpr (ALIGN_EPI) { if (wr == 1) PG8_BAR; }
    }
    PG8_WAIT_V(0);
    if constexpr (!ALIGN_EPI) { if (wr == 0) PG8_BAR; }
    PG8_BAR;
    if constexpr (Epi::AFTER_DRAIN) E.fused(acc, cur, wr, wc, fr, fq, lds, tid);
#undef PG8_SA
#undef PG8_SB
#undef PG8_STAGE
#undef PG8_STAGEB
#undef PG8_LDA
#undef PG8_LDB
#undef PG8_MMA
#undef PG8_WAIT_V
#undef PG8_WAIT_L
#undef PG8_BAR
#undef PG8_SCHED
}
}

#define XB_TMO      128
#define XB_XCNT(j)  (256  + 64 * (j))
#define XB_XSUB(j)  (1280 + 64 * (j))
#define XB_XGEN(j)  (2304 + 64 * (j))
#define XB_TOP      3328
#define XB_TOPGEN   3392
#define XCD_BAR_WORDS 3456
#define XB_SPIN_CAP (1u << 20)
__device__ __forceinline__ unsigned xb_ld(unsigned* p)              { return __hip_atomic_load(p, __ATOMIC_RELAXED, __HIP_MEMORY_SCOPE_AGENT); }
__device__ __forceinline__ unsigned xb_add(unsigned* p, unsigned v) { return __hip_atomic_fetch_add(p, v, __ATOMIC_RELAXED, __HIP_MEMORY_SCOPE_AGENT); }
__device__ __forceinline__ unsigned xb_xcc_id() { return (unsigned)__builtin_amdgcn_s_getreg((3 << 11) | 20) & 0xFu; }
#define XB_SPIN(cond, bar) do { unsigned _sp = 0; while (cond) { __builtin_amdgcn_s_sleep(1); \
    if ((++_sp & 255u) == 0u) { if (xb_ld(&(bar)[XB_TMO])) break; if (_sp > XB_SPIN_CAP) { atomicAdd(&(bar)[XB_TMO], 1u); break; } } } } while (0)
struct XcdBarrier { unsigned* bar; unsigned x; volatile LAS unsigned* st; };
__device__ __forceinline__ XcdBarrier xcd_barrier_post(unsigned* bar, volatile LAS unsigned* st) {
    XcdBarrier b; b.bar = bar; b.x = xb_xcc_id(); b.st = st;
    if (threadIdx.x == 0) (void)xb_add(&bar[XB_XCNT(b.x)], 1u);
    return b;
}
__device__ __forceinline__ void xcd_barrier_complete(unsigned* bar, unsigned x, unsigned& nloc, unsigned& nx) {
    const unsigned G = gridDim.x * gridDim.y * gridDim.z;
    unsigned sum, cnt, mine, sp = 0u;
    for (;;) {
        sum = 0u; cnt = 0u; mine = 0u;
#pragma unroll
        for (unsigned j = 0; j < 16; ++j) { const unsigned c = xb_ld(&bar[XB_XCNT(j)]); sum += c; cnt += (c > 0u) ? 1u : 0u; mine = (j == x) ? c : mine; }
        if (sum == G) break;
        __builtin_amdgcn_s_sleep(1);
        if ((++sp & 255u) == 0u) { if (xb_ld(&bar[XB_TMO])) break; if (sp > XB_SPIN_CAP) { atomicAdd(&bar[XB_TMO], 1u); break; } }
    }
    nloc = mine > 0u ? mine : 1u; nx = cnt > 0u ? cnt : 1u;
}
__device__ __forceinline__ void xcd_barrier(const XcdBarrier& b) {
    asm volatile("s_waitcnt vmcnt(0)" ::: "memory");
    __syncthreads();
    if (threadIdx.x == 0) {
        unsigned* bar = b.bar;
        __builtin_amdgcn_s_waitcnt(0);
        unsigned nloc = b.st[0], nx = b.st[1];
        if (nloc == 0u) { xcd_barrier_complete(bar, b.x, nloc, nx); b.st[0] = nloc; b.st[1] = nx; }
        const unsigned old = xb_add(&bar[XB_XSUB(b.x)], 1u);
        const unsigned gen = old / nloc;
        if (old + 1u == (gen + 1u) * nloc) {
            __builtin_amdgcn_fence(__ATOMIC_RELEASE, "agent");
            asm volatile("s_waitcnt vmcnt(0)" ::: "memory");
            const unsigned og = xb_add(&bar[XB_TOP], 1u);
            const unsigned tg = og / nx;
            if (og + 1u == (tg + 1u) * nx) xb_add(&bar[XB_TOPGEN], 1u);
            else XB_SPIN(xb_ld(&bar[XB_TOPGEN]) == tg, bar);
            __builtin_amdgcn_fence(__ATOMIC_ACQUIRE, "agent");
            xb_add(&bar[XB_XGEN(b.x)], 1u);
            asm volatile("s_waitcnt vmcnt(0)" ::: "memory");
        } else {
            XB_SPIN(xb_ld(&bar[XB_XGEN(b.x)]) == gen, bar);
            __builtin_amdgcn_fence(__ATOMIC_ACQUIRE, "agent");
            asm volatile("s_waitcnt vmcnt(0)" ::: "memory");
        }
    }
    __syncthreads();
}

__device__ __forceinline__ void xl_arrive(unsigned* ctr) {
    asm volatile("s_waitcnt vmcnt(0)" ::: "memory");
    __syncthreads();
    if (threadIdx.x == 0) xb_add(ctr, 1u);
}
__device__ __forceinline__ void xl_wait(unsigned* ctr, unsigned target) {
    if (threadIdx.x == 0) {
        unsigned sp = 0; while (xb_ld(ctr) < target) { __builtin_amdgcn_s_sleep(1); if (++sp > (1u << 22)) break; }
        __builtin_amdgcn_fence(__ATOMIC_ACQUIRE, "agent");
        asm volatile("s_waitcnt vmcnt(0)" ::: "memory");
    }
    __syncthreads();
}
__device__ __forceinline__ void xl_barrier(unsigned* ctr, unsigned target) {
    asm volatile("s_waitcnt vmcnt(0)" ::: "memory");
    __syncthreads();
    if (threadIdx.x == 0) {
        xb_add(ctr, 1u);
        unsigned sp = 0; while (xb_ld(ctr) < target) { __builtin_amdgcn_s_sleep(1); if (++sp > (1u << 22)) break; }
        __builtin_amdgcn_fence(__ATOMIC_ACQUIRE, "agent");
        asm volatile("s_waitcnt vmcnt(0)" ::: "memory");
    }
    __syncthreads();
}

struct Args { const float* in[18]; float* out; unsigned char* ws; int ph_lo, ph_hi, li, pad; };

struct Ctx {
    LAS unsigned char* lds;
    int tid, lane, wave, G, vcu, xcc, rank, vb;
    const float* const* in;
    float* out; unsigned char* ws;
};

constexpr int NPIECES = 43008;
constexpr int NBSLOT = 7, NBND = NBSLOT * 256 * 8;
struct Piece { const f32x4* s4; f32x4* d4; size_t n4, base; int W; };
__device__ __forceinline__ Piece piece_of(const float* const* in, float* out, int p, int lane) {
    const size_t v = (size_t)p * 1024; int t; size_t off;
    if (v < 1048576u) { t = 0; off = 0; } else if (v < 2097152u) { t = 1; off = 1048576u; } else if (v < 6291456u) { t = 2; off = 2097152u; } else if (v < 10485760u) { t = 3; off = 6291456u; }
    else if (v < 27262976u) { t = 4; off = 10485760u; } else { t = 5; off = 27262976u; }
    Piece P; P.W = 128 << (2 * (t >> 1)); P.n4 = (size_t)DEPTH * DEC_BATCH * P.W * 64;
    const size_t doff = t == 0 ? O_SK0 : t == 1 ? O_SV0 : t == 2 ? O_SK1 : t == 3 ? O_SV1 : t == 4 ? O_SK2 : O_SV2;
    P.s4 = (const f32x4*)in[2 + t]; P.d4 = (f32x4*)(out + doff); P.base = v - off + lane; return P;
}
#define PC_LOAD(R, P, U0, U1) _Pragma("unroll") for (int u_ = (U0); u_ < (U1); ++u_) { const size_t i_ = (P).base + 64 * u_; R[u_] = __builtin_nontemporal_load(&(P).s4[i_ + 64 < (P).n4 ? i_ + 64 : i_]); } __builtin_amdgcn_sched_barrier(0);
#define PC_STORE(R, P, U0, U1) _Pragma("unroll") for (int u_ = (U0); u_ < (U1); ++u_) { const size_t i_ = (P).base + 64 * u_; const int within_ = (int)((i_ >> 6) & (size_t)((P).W - 1)); if (within_ < (P).W - 1) __builtin_nontemporal_store(R[u_], &(P).d4[i_]); }

struct Epi1 {
    static constexpr bool PERM = true, AFTER_DRAIN = false, B_NT = false, WAIT_A = false, WAIT_MID = false;
    static __device__ __forceinline__ bool keep_acc(const pg8::Unit&) { return false; }
    bf16_t* Z; const float* rope; float* out; int layer; const float* const* in; int cslot, cwg;
    __device__ __forceinline__ void operator()(f32x4 (&acc)[2][2][4][2], const pg8::Unit& u, int wr, int wc, int fr, int fq, int ui) const {
        const int ck = (ui & 2) ? 4 : (ui & 1) + 2 * (ui >> 2);
        const int pid = (ck < 4) ? NBND + ((cslot + ck) * NG1 + cwg) * 8 + (wr * 4 + wc) : NPIECES;
        const bool havep = pid < NPIECES;
        Piece CP = piece_of(in, out, havep ? pid : 0, fq * 16 + fr); f32x4 cpr[16];
        if (havep) { PC_LOAD(cpr, CP, 0, 8) }
        __builtin_amdgcn_sched_barrier(0);
        const int pn = u.pn;
        const int row0 = u.pm * 256 + wr * 64 + fr;
        const int colw = wc * 32 + 8 * fq;
        const bool is_rope = (pn < 6) && ((wc & 1) == 0);
        const float qs = (pn < 3) ? QSCALE : 1.0f;
        const bool is_kv = (pn >= 3) && (pn < 9);
        const bool is_glu = (pn >= 12) && (pn < 18);
        const int g = is_kv ? (pn - 3) % 3 : 0; const bool isv = pn >= 6;
        const int Wg = 128 << (2 * g);
        size_t pbase, sbase;
        { const size_t pk[3] = {O_PK0, O_PK1, O_PK2}, pv[3] = {O_PV0, O_PV1, O_PV2}, sk[3] = {O_SK0, O_SK1, O_SK2}, sv[3] = {O_SV0, O_SV1, O_SV2};
          pbase = isv ? pv[g] : pk[g]; sbase = isv ? sv[g] : sk[g]; }
        const float sgn = (fq == 0) ? -1.0f : 1.0f;
#pragma unroll
        for (int ai = 0; ai < 2; ++ai)
#pragma unroll
            for (int m = 0; m < 4; ++m) {
                if (ai == 1 && m == 0) { __builtin_amdgcn_sched_barrier(0); if (havep) { PC_LOAD(cpr, CP, 8, 16) } }
                const int r = row0 + ai * 128 + m * 16;
                f32x4 cs0, cs1, sn0, sn1;
                if (is_rope) {
                    const int pidx = (r < MP) ? (r & 2047) : 2048;
                    const f32x4* rp = (const f32x4*)(rope + (size_t)pidx * 16);
                    cs0 = rp[0]; cs1 = rp[1]; sn0 = rp[2]; sn1 = rp[3];
                }
                float* st_dst = nullptr;
                if (is_kv) {
                    if (r < MP) { const int b = r >> 11, s = r & 2047; if (s >= 2048 - Wg) st_dst = out + pbase + ((size_t)((layer * 8 + b) * Wg + (s - (2048 - Wg)))) * 256 + colw; }
                    else if (r < MR) { const int b = r - MP; st_dst = out + sbase + ((size_t)((layer * 32 + b) * Wg + (Wg - 1))) * 256 + colw; }
                }
                bf16_t* zrow = Z + (size_t)r * ZN + pn * 256 + colw;
                if (is_glu) {
                    const f32x4 a0 = acc[ai][0][m][0], a1 = acc[ai][0][m][1], b0 = acc[ai][1][m][0], b1 = acc[ai][1][m][1];
                    f32x4 u0, u1;
#pragma unroll
                    for (int e = 0; e < 4; ++e) { u0[e] = a0[e] * sigmoidf_(b0[e]); u1[e] = a1[e] * sigmoidf_(b1[e]); }
                    u32x4 w; w.x = cvt_pk_bf16(u0[0], u0[1]); w.y = cvt_pk_bf16(u0[2], u0[3]); w.z = cvt_pk_bf16(u1[0], u1[1]); w.w = cvt_pk_bf16(u1[2], u1[3]);
                    *(u32x4*)zrow = w;
                    const int s = r & 2047;
                    if (s >= 2018) { float* pc = out + O_PC + ((size_t)((layer * 8 + (r >> 11)) * 30 + (s - 2018))) * 768 + (pn - 12) * 128 + colw; __builtin_nontemporal_store(u0, (f32x4*)pc); __builtin_nontemporal_store(u1, (f32x4*)(pc + 4)); }
                    continue;
                }
#pragma unroll
                for (int bj = 0; bj < 2; ++bj) {
                    f32x4 v0 = acc[ai][bj][m][0], v1 = acc[ai][bj][m][1];
                    if (is_rope) {
                        f32x4 p0, p1;
#pragma unroll
                        for (int e = 0; e < 4; ++e) { p0[e] = __shfl_xor(v0[e], 16); p1[e] = __shfl_xor(v1[e], 16); }
                        if (fq < 2) { v0 = v0 * cs0 + (p0 * sn0) * sgn; v1 = v1 * cs1 + (p1 * sn1) * sgn; }
                    }
                    v0 = v0 * qs; v1 = v1 * qs;
                    if (st_dst) { __builtin_nontemporal_store(v0, (f32x4*)(st_dst + bj * 128)); __builtin_nontemporal_store(v1, (f32x4*)(st_dst + bj * 128 + 4)); }
                    u32x4 w; w.x = cvt_pk_bf16(v0[0], v0[1]); w.y = cvt_pk_bf16(v0[2], v0[3]); w.z = cvt_pk_bf16(v1[0], v1[1]); w.w = cvt_pk_bf16(v1[2], v1[3]);
                    *(u32x4*)(zrow + bj * 128) = w;
                }
            }
        __builtin_amdgcn_sched_barrier(0);
        if (havep) { PC_STORE(cpr, CP, 0, 16) }
    }
};

struct Epi2 {
    static constexpr bool PERM = true, AFTER_DRAIN = false, B_NT = false, WAIT_A = true, WAIT_MID = true;
    static __device__ __forceinline__ bool keep_acc(const pg8::Unit& u) { return u.which == 0; }
    const bf16_t* Z; bf16_t* MG; unsigned* xc; unsigned* xp; unsigned xtarget;
    __device__ __forceinline__ void wait_ctr(const unsigned* ctr, int tid) const {
        if (tid == 0) { unsigned sp = 0; while (xb_ld((unsigned*)ctr) < xtarget) { __builtin_amdgcn_s_sleep(1); if (++sp > (1u << 22)) break; }
            __builtin_amdgcn_fence(__ATOMIC_ACQUIRE, "agent"); }
        __builtin_amdgcn_s_barrier();
    }
    __device__ __forceinline__ void pre_a(const pg8::Unit&, int tid) const { wait_ctr(xc, tid); }
    __device__ __forceinline__ void mid_wait(int tid) const { wait_ctr(xp, tid); }
    __device__ __forceinline__ void operator()(f32x4 (&acc)[2][2][4][2], const pg8::Unit& u, int wr, int wc, int fr, int fq, int ui) const {
        const int row0 = u.pm * 256 + wr * 64 + fr, col0 = u.pn * 256 + wc * 32 + 8 * fq;
#pragma unroll
        for (int ai = 0; ai < 2; ++ai) {
            u32x4 gc_[4][2], ga_[4][2];
#pragma unroll
            for (int m = 0; m < 4; ++m)
#pragma unroll
                for (int bj = 0; bj < 2; ++bj) { const int r = row0 + ai * 128 + m * 16;
                    gc_[m][bj] = (u.which == 0) ? *(const u32x4*)(Z + (size_t)r * ZN + ZC_MA + col0 + bj * 128) : __builtin_nontemporal_load((const u32x4*)(Z + (size_t)r * ZN + ZC_MA + col0 + bj * 128));
                    ga_[m][bj] = (u.which == 0) ? __builtin_nontemporal_load((const u32x4*)(Z + (size_t)r * ZN + ZC_MC + col0 + bj * 128)) : (u32x4){0u, 0u, 0u, 0u}; }
            __builtin_amdgcn_sched_barrier(0);
#pragma unroll
            for (int m = 0; m < 4; ++m)
#pragma unroll
                for (int bj = 0; bj < 2; ++bj) { const int r = row0 + ai * 128 + m * 16;
                    const u32x4 c = gc_[m][bj], a = ga_[m][bj];
                    f32x4 v0 = acc[ai][bj][m][0], v1 = acc[ai][bj][m][1];
                    if (u.which == 0) {
                        v0[0] *= sigmoidf_(bf_lo(a.x)) * (1.0f + __expf(-bf_lo(c.x))); v0[1] *= sigmoidf_(bf_hi(a.x)) * (1.0f + __expf(-bf_hi(c.x))); v0[2] *= sigmoidf_(bf_lo(a.y)) * (1.0f + __expf(-bf_lo(c.y))); v0[3] *= sigmoidf_(bf_hi(a.y)) * (1.0f + __expf(-bf_hi(c.y)));
                        v1[0] *= sigmoidf_(bf_lo(a.z)) * (1.0f + __expf(-bf_lo(c.z))); v1[1] *= sigmoidf_(bf_hi(a.z)) * (1.0f + __expf(-bf_hi(c.z))); v1[2] *= sigmoidf_(bf_lo(a.w)) * (1.0f + __expf(-bf_lo(c.w))); v1[3] *= sigmoidf_(bf_hi(a.w)) * (1.0f + __expf(-bf_hi(c.w)));
                        acc[ai][bj][m][0] = v0; acc[ai][bj][m][1] = v1;
                    } else {
                        v0[0] *= sigmoidf_(bf_lo(c.x)); v0[1] *= sigmoidf_(bf_hi(c.x)); v0[2] *= sigmoidf_(bf_lo(c.y)); v0[3] *= sigmoidf_(bf_hi(c.y));
                        v1[0] *= sigmoidf_(bf_lo(c.z)); v1[1] *= sigmoidf_(bf_hi(c.z)); v1[2] *= sigmoidf_(bf_lo(c.w)); v1[3] *= sigmoidf_(bf_hi(c.w));
                        u32x4 w; w.x = cvt_pk_bf16(v0[0], v0[1]); w.y = cvt_pk_bf16(v0[2], v0[3]); w.z = cvt_pk_bf16(v1[0], v1[1]); w.w = cvt_pk_bf16(v1[2], v1[3]);
                        *(u32x4*)(MG + (size_t)r * 1024 + col0 + bj * 128) = w;
                    } }
            __builtin_amdgcn_sched_barrier(0);
        }
    }
};

template <bool FIRST>
struct Epi3F {
    static constexpr bool PERM = true, AFTER_DRAIN = true, B_NT = false, WAIT_A = true, WAIT_MID = false;
    static __device__ __forceinline__ bool keep_acc(const pg8::Unit&) { return false; }
    __device__ __forceinline__ void pre_a(const pg8::Unit& u, int tid) const {
        if (tid == 0) { unsigned sp = 0; while (xb_ld(cnt1 + 64 * u.pm) < target) { __builtin_amdgcn_s_sleep(1); if (++sp > (1u << 22)) break; }
            __builtin_amdgcn_fence(__ATOMIC_ACQUIRE, "agent"); }
        __builtin_amdgcn_s_barrier();
    }
    const float* xsrc; float* y; bf16_t* H; const float* gpost; const float* gpre; float* xb1; float* xb2; unsigned* cnt1; unsigned* cnt2; unsigned target; int last; const float* gprev; float* RS;
    static constexpr bool first = FIRST;
    __device__ __forceinline__ void row_rs(const f32x4 (&v)[2][2][4][2], const pg8::Unit& u, int wr, int wc, int fr, int fq, LAS unsigned char* lds, int tid, float* xb, unsigned* cnt) const {
        LAS float* P = (LAS float*)lds; LAS float* S = P + 1024;
#pragma unroll
        for (int ai = 0; ai < 2; ++ai)
#pragma unroll
            for (int m = 0; m < 4; ++m) { float s = 0.f;
#pragma unroll
                for (int bj = 0; bj < 2; ++bj)
#pragma unroll
                    for (int n = 0; n < 2; ++n) { const f32x4 t = v[ai][bj][m][n]; s += (t[0] * t[0] + t[1] * t[1]) + (t[2] * t[2] + t[3] * t[3]); }
                s += __shfl_xor(s, 16); s += __shfl_xor(s, 32);
                if (fq == 0) P[(ai * 128 + wr * 64 + m * 16 + fr) * 4 + wc] = s; }
        __syncthreads();
        if (tid < 256) { const float t = (P[tid * 4] + P[tid * 4 + 1]) + (P[tid * 4 + 2] + P[tid * 4 + 3]);
            unsigned long long* q = (unsigned long long*)xb + ((size_t)u.pm * 256 + tid) * 4;
            __hip_atomic_store(q + u.pn, ((unsigned long long)target << 32) | __float_as_uint(t), RLX_AGENT);
            float tot = 0.f;
#pragma unroll
            for (int j = 0; j < 4; ++j) { unsigned long long w = __hip_atomic_load(q + j, RLX_AGENT); unsigned sp = 0;
                while ((unsigned)(w >> 32) != target) { __builtin_amdgcn_s_sleep(1); w = __hip_atomic_load(q + j, RLX_AGENT); if (++sp > (1u << 22)) break; }
                tot += __uint_as_float((unsigned)w); }
            S[tid] = 1.0f / sqrtf(tot * (1.f / 1024.f) + RMS_EPS); }
        __syncthreads();
    }
    __device__ __forceinline__ void fused(f32x4 (&acc)[2][2][4][2], const pg8::Unit& u, int wr, int wc, int fr, int fq, LAS unsigned char* lds, int tid) const {
        const LAS float* S = (const LAS float*)lds + 1024;
        const int col0 = u.pn * 256 + wc * 32 + 8 * fq;
        u32x4 hv0[4][2]; float rp[2][4]; f32x4 gi[2][2];
#pragma unroll
        for (int m = 0; m < 4; ++m)
#pragma unroll
            for (int bj = 0; bj < 2; ++bj) hv0[m][bj] = *(const u32x4*)(H + (size_t)(u.pm * 256 + wr * 64 + m * 16 + fr) * 1024 + col0 + bj * 128);
#pragma unroll
        for (int ai = 0; ai < 2; ++ai)
#pragma unroll
            for (int m = 0; m < 4; ++m) rp[ai][m] = RS[u.pm * 256 + ai * 128 + wr * 64 + m * 16 + fr];
#pragma unroll
        for (int bj = 0; bj < 2; ++bj)
#pragma unroll
            for (int n = 0; n < 2; ++n) gi[bj][n] = *(const f32x4*)(gprev + col0 + bj * 128 + n * 4);
        __builtin_amdgcn_sched_barrier(0);
        row_rs(acc, u, wr, wc, fr, fq, lds, tid, xb1, cnt1);
#pragma unroll
        for (int ai = 0; ai < 2; ++ai)
#pragma unroll
            for (int m = 0; m < 4; ++m) rp[ai][m] = __builtin_amdgcn_rcpf(rp[ai][m]);
#pragma unroll
        for (int bj = 0; bj < 2; ++bj)
#pragma unroll
            for (int n = 0; n < 2; ++n)
#pragma unroll
                for (int e = 0; e < 4; ++e) gi[bj][n][e] = __builtin_amdgcn_rcpf(gi[bj][n][e]);
        f32x4 gp[2][2];
#pragma unroll
        for (int bj = 0; bj < 2; ++bj)
#pragma unroll
            for (int n = 0; n < 2; ++n) gp[bj][n] = *(const f32x4*)(gpost + col0 + bj * 128 + n * 4);
#pragma unroll
        for (int ai = 0; ai < 2; ++ai) {
            u32x4 hv[4][2];
#pragma unroll
            for (int m = 0; m < 4; ++m)
#pragma unroll
                for (int bj = 0; bj < 2; ++bj) hv[m][bj] = (ai == 0) ? hv0[m][bj] : *(const u32x4*)(H + (size_t)(u.pm * 256 + 128 + wr * 64 + m * 16 + fr) * 1024 + col0 + bj * 128);
            __builtin_amdgcn_sched_barrier(0);
#pragma unroll
            for (int m = 0; m < 4; ++m) { const float rs = S[ai * 128 + wr * 64 + m * 16 + fr];
#pragma unroll
                for (int bj = 0; bj < 2; ++bj) { const u32x4 hh = hv[m][bj];
                    const f32x4 x0 = (f32x4){bf_lo(hh.x), bf_hi(hh.x), bf_lo(hh.y), bf_hi(hh.y)} * gi[bj][0] * rp[ai][m], x1 = (f32x4){bf_lo(hh.z), bf_hi(hh.z), bf_lo(hh.w), bf_hi(hh.w)} * gi[bj][1] * rp[ai][m];
                    acc[ai][bj][m][0] = x0 + (acc[ai][bj][m][0] * rs) * gp[bj][0]; acc[ai][bj][m][1] = x1 + (acc[ai][bj][m][1] * rs) * gp[bj][1]; } }
            __builtin_amdgcn_sched_barrier(0);
        }
        if (!last) {
            __syncthreads();
            row_rs(acc, u, wr, wc, fr, fq, lds, tid, xb2, cnt2);
            if (u.pn == 0 && tid < 256) RS[u.pm * 256 + tid] = S[tid];
#pragma unroll
            for (int bj = 0; bj < 2; ++bj)
#pragma unroll
                for (int n = 0; n < 2; ++n) gp[bj][n] = *(const f32x4*)(gpre + col0 + bj * 128 + n * 4);
        }
#pragma unroll
        for (int ai = 0; ai < 2; ++ai)
#pragma unroll
            for (int m = 0; m < 4; ++m) { const int rl = ai * 128 + wr * 64 + m * 16 + fr; const size_t off = (size_t)(u.pm * 256 + rl) * 1024 + col0; const float rs2 = S[rl];
#pragma unroll
                for (int bj = 0; bj < 2; ++bj) { const f32x4 x0 = acc[ai][bj][m][0], x1 = acc[ai][bj][m][1];
                    if (last) { __builtin_nontemporal_store(x0, (f32x4*)(y + off + bj * 128)); __builtin_nontemporal_store(x1, (f32x4*)(y + off + bj * 128 + 4)); }
                    else { const f32x4 h0 = (x0 * rs2) * gp[bj][0], h1 = (x1 * rs2) * gp[bj][1]; u32x4 w; w.x = cvt_pk_bf16(h0[0], h0[1]); w.y = cvt_pk_bf16(h0[2], h0[3]); w.z = cvt_pk_bf16(h1[0], h1[1]); w.w = cvt_pk_bf16(h1[2], h1[3]);
                        *(u32x4*)(H + off + bj * 128) = w; } } }
    }
};

struct TrItem { const float* W; bf16_t* WT; int K, N, item; bool remap; };
__device__ __forceinline__ void tr_load(const TrItem& T, int lane, float (&wr_)[32]) {
    const int nblk = T.N / 32, kb = T.item / nblk, nb = T.item % nblk, k0 = 64 * kb, n0 = 32 * nb;
#pragma unroll
    for (int i = 0; i < 32; ++i) { const int kk = 2 * i + (lane >> 5); wr_[i] = __builtin_nontemporal_load(&T.W[(size_t)(k0 + kk) * T.N + n0 + (lane & 31)]); }
    __builtin_amdgcn_sched_barrier(0);
}
__device__ __forceinline__ void tr_finish(const TrItem& T, LAS float* scr, int lane, const float (&wr_)[32]) {
    const int nblk = T.N / 32, kb = T.item / nblk, nb = T.item % nblk, k0 = 64 * kb, n0 = 32 * nb;
    int r0 = n0;
    if (T.remap && n0 >= ZC_CA && n0 < ZC_GC) r0 = (n0 < ZC_CB) ? zc_ca(n0 - ZC_CA) : zc_ca(n0 - ZC_CB) + 128;
#pragma unroll
    for (int i = 0; i < 32; ++i) { const int kk = 2 * i + (lane >> 5); scr[kk * 33 + (lane & 31)] = wr_[i]; }
    LDS_WAIT(); asm volatile("" ::: "memory");
    const int c = lane & 7;
#pragma unroll
    for (int j = 0; j < 4; ++j) { const int n = (lane >> 3) + 8 * j; const LAS float* s = scr + (8 * c) * 33 + n;
        u32x4 o; o.x = cvt_pk_bf16(s[0 * 33], s[1 * 33]); o.y = cvt_pk_bf16(s[2 * 33], s[3 * 33]); o.z = cvt_pk_bf16(s[4 * 33], s[5 * 33]); o.w = cvt_pk_bf16(s[6 * 33], s[7 * 33]);
        *(u32x4*)(T.WT + (size_t)(r0 + n) * T.K + k0 + 8 * c) = o; }
    LDS_WAIT(); asm volatile("" ::: "memory");
}
__device__ __forceinline__ TrItem tr_decode(Ctx& X, int it) {
    constexpr int I_IN = (1024 / 64) * (ZN / 32), I_AO = (768 / 64) * (1024 / 32);
    constexpr int PER_L = I_IN + 2 * I_AO + (1024 / 64) * (1024 / 32);
    const int l = it / PER_L; int r = it % PER_L; TrItem T;
    if (r < I_IN) { T.W = X.in[9] + (size_t)l * 1024 * ZN; T.WT = (bf16_t*)(X.ws + WS_WIN + l * SZ_WIN1); T.K = 1024; T.N = ZN; T.item = r; T.remap = true; return T; } r -= I_IN;
    if (r < I_AO) { T.W = X.in[10] + (size_t)l * 768 * 1024; T.WT = (bf16_t*)(X.ws + WS_WAO + l * SZ_WAO1); T.K = 768; T.N = 1024; T.item = r; T.remap = false; return T; } r -= I_AO;
    if (r < I_AO) { T.W = X.in[11] + (size_t)l * 768 * 1024; T.WT = (bf16_t*)(X.ws + WS_WCO + l * SZ_WAO1); T.K = 768; T.N = 1024; T.item = r; T.remap = false; return T; } r -= I_AO;
    T.W = X.in[12] + (size_t)l * 1024 * 1024; T.WT = (bf16_t*)(X.ws + WS_WO + l * SZ_WO1); T.K = 1024; T.N = 1024; T.item = r; T.remap = false; return T;
}
__device__ __forceinline__ void weight_transposes(Ctx& X, int gw0, int ngw) {
    LAS float* scr = (LAS float*)(X.lds + X.wave * 16384);
    constexpr int NITEMS = 4 * ((1024 / 64) * (ZN / 32) + 2 * (768 / 64) * (1024 / 32) + (1024 / 64) * (1024 / 32));
    int it = gw0; if (it >= NITEMS) return;
    float ra[32], rb[32];
    TrItem Tc = tr_decode(X, it); tr_load(Tc, X.lane, ra);
#pragma unroll 1
    for (;;) {
        const int itn = it + ngw; const bool more = itn < NITEMS;
        TrItem Tn = Tc; if (more) { Tn = tr_decode(X, itn); tr_load(Tn, X.lane, rb); }
        tr_finish(Tc, scr, X.lane, ra);
        if (!more) break;
#pragma unroll
        for (int i = 0; i < 32; ++i) ra[i] = rb[i];
        Tc = Tn; it = itn;
    }
}
__device__ __forceinline__ void rms_row_to_bf16(const float* xrow, const float* g, bf16_t* orow, int lane, float* rs_out) {
    const f32x4* xr = (const f32x4*)xrow + lane; const f32x4* gr = (const f32x4*)g + lane;
    f32x4 v[4], gv[4]; float s = 0.f;
#pragma unroll
    for (int j = 0; j < 4; ++j) { v[j] = xr[64 * j]; gv[j] = gr[64 * j]; }
    __builtin_amdgcn_sched_barrier(0);
#pragma unroll
    for (int j = 0; j < 4; ++j) s += (v[j].x * v[j].x + v[j].y * v[j].y) + (v[j].z * v[j].z + v[j].w * v[j].w);
    const float rs = 1.0f / sqrtf(wave_sum(s) * (1.f / 1024.f) + RMS_EPS);
    if (rs_out && lane == 0) *rs_out = rs;
    u32x2* o8 = (u32x2*)orow + lane;
#pragma unroll
    for (int j = 0; j < 4; ++j) { const f32x4 gg = gv[j]; u32x2 w; w.x = cvt_pk_bf16(v[j].x * rs * gg.x, v[j].y * rs * gg.y); w.y = cvt_pk_bf16(v[j].z * rs * gg.z, v[j].w * rs * gg.w); o8[64 * j] = w; }
}
__device__ __forceinline__ void p0_prep(Ctx& X) {
    const int gw = X.vcu * NWAVES + X.wave, NGW = X.G * NWAVES;
    weight_transposes(X, gw, NGW);
    {
        float* rope = (float*)(X.ws + WS_ROPE);
        const int gt = X.vcu * 512 + X.tid, NT = X.G * 512;
        for (int i = gt; i < 2049 * 8; i += NT) {
            const int pidx = i >> 3, e = i & 7; const int pos = (pidx < 2048) ? pidx : 8192;
            const float inv = e == 0 ? 1.0f : e == 1 ? 0.19392274474868576f : e == 2 ? 0.03760603093086393f : e == 3 ? 0.007292664737217109f : e == 4 ? 0.001414213562373095f
                            : e == 5 ? 0.0002742481756762073f : e == 6 ? 5.318295896944988e-05f : 1.031338537721246e-05f;
            const float ang = (float)pos * inv;
            const float k = rintf(ang * 0.15915494309189535f);
            float r = fmaf(-k, 6.2831854820251465f, ang); r = fmaf(-k, -1.7484556025237907e-07f, r);
            const float rev = r * 0.15915494309189535f;
            rope[pidx * 16 + e] = __builtin_amdgcn_cosf(rev); rope[pidx * 16 + 8 + e] = __builtin_amdgcn_sinf(rev);
        }
    }
    {
        float* cwt = (float*)(X.ws + WS_CWT);
        const int gt = X.vcu * 512 + X.tid, NT = X.G * 512;
        for (int i = gt; i < 4 * 768 * 32; i += NT) { const int l = i / (768 * 32), r = i % (768 * 32), c = r >> 5, k = r & 31; cwt[i] = (k < 31) ? X.in[13][((size_t)l * 31 + k) * 768 + c] : 0.f; }
    }
    {
        bf16_t* H = (bf16_t*)(X.ws + WS_H);
        for (int m = gw; m < MPAD; m += NGW) {
            if (m < MR) { const float* xr = (m < MP) ? X.in[0] + (size_t)m * 1024 : X.in[1] + (size_t)(m - MP) * 1024; rms_row_to_bf16(xr, X.in[16], H + (size_t)m * 1024, X.lane, (m < MP) ? (float*)(X.ws + WS_RS) + m : nullptr); }
            else { u32x4* o = (u32x4*)(H + (size_t)m * 1024) + X.lane; o[0] = (u32x4){0u, 0u, 0u, 0u}; o[64] = (u32x4){0u, 0u, 0u, 0u}; }
        }
    }
}

__device__ __forceinline__ int crow(int r, int hi) { return (r & 3) + 8 * (r >> 2) + 4 * hi; }
__device__ __forceinline__ s16x4 vtr(LAS const unsigned char* p) { typedef short v4i16_t __attribute__((ext_vector_type(4))); return __builtin_bit_cast(s16x4, __builtin_amdgcn_ds_read_tr16_b64_v4i16((LAS v4i16_t*)p)); }

__device__ __forceinline__ void conv_issue(const bf16_t* Z, int unit, int tid, u32x4 (&ra)[12]);
struct AttnGeo { int h, dsh, c0, tb0, tw0, two; };
__device__ __forceinline__ AttnGeo attn_geo(int u) {
    AttnGeo G; G.h = u >> 3; const int sub = u & 7, g = G.h >> 2; G.dsh = 2 * g;
    if (g == 0) { G.c0 = 0; G.tb0 = 8 * sub; G.tw0 = 256 * sub - 128; G.two = 0; }
    else if (g == 1) { G.c0 = sub >> 1; G.tb0 = 8 * (sub & 1); G.tw0 = 256 * (sub & 1) - 128; G.two = 0; }
    else { G.c0 = 2 * sub; G.tb0 = 0; G.tw0 = 0; G.two = 1; }
    return G;
}
constexpr int AT_OST = 98304, AT_SCR = 131072;
__device__ __forceinline__ void attn_issue(const bf16_t* Z, int b, int u, int tid, u32x4 (&pf)[12]) {
    const AttnGeo G = attn_geo(u);
    const size_t rowb = (size_t)b * 2048; const int isv = tid >> 8, ch = tid & 255, key = ch >> 3, dch = ch & 7;
    const int col = (isv ? ZC_V : ZC_K) + G.h * 64 + dch * 8;
#pragma unroll
    for (int s = 0; s < 12; ++s) {
        int t, c; if (G.two) { t = 32 * (s & 3) + key; c = G.c0 + (s >> 2); } else { t = G.tw0 + 32 * s + key; c = G.c0; }
        const bool ok = G.two ? (s < 8) : (t >= 0);
        const size_t m = rowb + ((size_t)(ok ? t : 0) << G.dsh) + c;
        pf[s] = ok ? __builtin_nontemporal_load((const u32x4*)(Z + m * ZN + col)) : (u32x4){0u, 0u, 0u, 0u};
    }
    __builtin_amdgcn_sched_barrier(0);
}
__device__ __forceinline__ void attn_issue_q(const bf16_t* Z, int b, int u, int wave, int lane, bf16x8 (&qn)[4]) {
    const AttnGeo G = attn_geo(u); const size_t rowb = (size_t)b * 2048;
    const int r32 = lane & 31, hi = lane >> 5;
    const int cw = G.two ? G.c0 + (wave >> 2) : G.c0, tb = G.two ? (wave & 3) : G.tb0 + wave;
    const size_t mq = rowb + ((size_t)(tb * 32 + r32) << G.dsh) + cw;
#pragma unroll
    for (int d0 = 0; d0 < 4; ++d0) qn[d0] = *(const bf16x8*)(Z + mq * ZN + ZC_Q + G.h * 64 + d0 * 16 + hi * 8);
    __builtin_amdgcn_sched_barrier(0);
}
__device__ __forceinline__ void attn_stage_write(LAS unsigned char* lds, int tid, const u32x4 (&pf)[12]) {
    const int isv = tid >> 8, ch = tid & 255, key = ch >> 3, dch = ch & 7;
    const int off = isv ? 4096 + (dch >> 2) * 2048 + (key >> 4) * 1024 + ((key >> 3) & 1) * 512 + (key & 7) * 64 + (dch & 3) * 16 : key * 128 + ((dch ^ (key & 7)) << 4);
#pragma unroll
    for (int s = 0; s < 12; ++s) *(LAS u32x4*)(lds + s * 8192 + off) = pf[s];
}
__device__ __forceinline__ void attn_compute(const bf16_t* Z, bf16_t* A2, float* LSE, int b, int u, int un, LAS unsigned char* lds, int tid, int wave, int lane, u32x4 (&pf)[12], bf16x8 (&qr)[4], int cunit) {
    const AttnGeo G = attn_geo(u);
    const int r32 = lane & 31, hi = lane >> 5; const int h = G.h, dsh = G.dsh;
    const int c = G.two ? G.c0 + (wave >> 2) : G.c0, tb = G.two ? (wave & 3) : G.tb0 + wave;
    const int sl0 = G.two ? 4 * (wave >> 2) + (wave & 3) - 4 : wave;
    const size_t rowb = (size_t)b * 2048; const size_t mq = rowb + ((size_t)(tb * 32 + r32) << dsh) + c;
    const int jlo = tb >= 4 ? 0 : 4 - tb;
    f32x16 S[5]; const float NEG = -INFINITY;
#pragma unroll
    for (int j = 0; j < 5; ++j) {
        if (j >= jlo) {
            const LAS unsigned char* kb = lds + (sl0 + j) * 8192 + r32 * 128;
            bf16x8 kf[4];
#pragma unroll
            for (int d0 = 0; d0 < 4; ++d0) kf[d0] = *(const LAS bf16x8*)(kb + (((2 * d0 + hi) ^ (r32 & 7)) << 4));
            f32x16 a = {};
#pragma unroll
            for (int d0 = 0; d0 < 4; ++d0) a = __builtin_amdgcn_mfma_f32_32x32x16_bf16(kf[d0], qr[d0], a, 0, 0, 0);
            S[j] = a;
        } else {
#pragma unroll
            for (int r = 0; r < 16; ++r) S[j][r] = NEG;
        }
    }
    if (jlo == 0) {
#pragma unroll
        for (int r = 0; r < 16; ++r) if (crow(r, hi) < r32) S[0][r] = NEG;
    }
#pragma unroll
    for (int r = 0; r < 16; ++r) if (crow(r, hi) > r32) S[4][r] = NEG;
    float mx = NEG;
#pragma unroll
    for (int j = 0; j < 5; ++j)
#pragma unroll
        for (int r = 0; r < 16; ++r) mx = fmaxf(mx, S[j][r]);
    mx = fmaxf(mx, __shfl_xor(mx, 32));
    float l = 0.f;
#pragma unroll
    for (int j = 0; j < 5; ++j)
#pragma unroll
        for (int r = 0; r < 16; ++r) { const float p = __builtin_amdgcn_exp2f(S[j][r] - mx); S[j][r] = p; l += p; }
    l += __shfl_xor(l, 32);
    LAS float* scr = (LAS float*)(lds + AT_SCR + wave * 256);
    if (hi == 0) { scr[r32] = __builtin_amdgcn_rcpf(l); LSE[(mq * 4 + (h & 3)) * 4 + (h >> 2)] = (mx + __builtin_amdgcn_logf(l)) * LN2; }
    u32x4 pw[5][2];
#pragma unroll
    for (int j = 0; j < 5; ++j)
#pragma unroll
        for (int s = 0; s < 2; ++s) { pw[j][s].x = cvt_pk_bf16(S[j][8 * s + 0], S[j][8 * s + 1]); pw[j][s].y = cvt_pk_bf16(S[j][8 * s + 2], S[j][8 * s + 3]); pw[j][s].z = cvt_pk_bf16(S[j][8 * s + 4], S[j][8 * s + 5]); pw[j][s].w = cvt_pk_bf16(S[j][8 * s + 6], S[j][8 * s + 7]); }
    __builtin_amdgcn_sched_barrier(0);
    if (un < 96) attn_issue(Z, b, un, tid, pf);
    else conv_issue(Z, cunit, tid, pf);
    f32x16 o0 = {}, o1 = {};
    const int vrd = 4096 + (4 * hi + ((lane & 15) >> 2)) * 64 + ((lane >> 4) & 1) * 32 + (lane & 3) * 8;
#pragma unroll
    for (int j = 0; j < 5; ++j) {
        if (j >= jlo) {
            const LAS unsigned char* vb = lds + (sl0 + j) * 8192 + vrd;
#pragma unroll
            for (int s = 0; s < 2; ++s) {
                const bf16x8 pa = __builtin_bit_cast(bf16x8, pw[j][s]);
                { const s16x4 lo = vtr(vb + s * 1024), hh = vtr(vb + s * 1024 + 512);
                  const bf16x8 vf = (bf16x8){lo[0], lo[1], lo[2], lo[3], hh[0], hh[1], hh[2], hh[3]};
                  o0 = __builtin_amdgcn_mfma_f32_32x32x16_bf16(pa, vf, o0, 0, 0, 0); }
                { const s16x4 lo = vtr(vb + 2048 + s * 1024), hh = vtr(vb + 2048 + s * 1024 + 512);
                  const bf16x8 vf = (bf16x8){lo[0], lo[1], lo[2], lo[3], hh[0], hh[1], hh[2], hh[3]};
                  o1 = __builtin_amdgcn_mfma_f32_32x32x16_bf16(pa, vf, o1, 0, 0, 0); }
            }
        }
    }
    LDS_WAIT();
    LAS bf16_t* stg = (LAS bf16_t*)(lds + AT_OST + wave * 4096);
#pragma unroll
    for (int r = 0; r < 16; ++r) { const int orow = crow(r, hi); const float rl = scr[orow];
        stg[orow * 64 + r32] = (bf16_t)(cvt_pk_bf16(o0[r] * rl, 0.f) & 0xffffu); stg[orow * 64 + 32 + r32] = (bf16_t)(cvt_pk_bf16(o1[r] * rl, 0.f) & 0xffffu); }
    LDS_WAIT();
#pragma unroll
    for (int i = 0; i < 4; ++i) { const int row = i * 8 + (lane >> 3), ch = lane & 7; const u32x4 v = *(const LAS u32x4*)(stg + row * 64 + ch * 8);
        const size_t mo = rowb + ((size_t)(tb * 32 + row) << dsh) + c;
        *(u32x4*)(A2 + mo * AW + h * 64 + ch * 8) = v; }
    LDS_WAIT();
}
__device__ __forceinline__ void attn_prompt_wg(Ctx& X, const bf16_t* Z, bf16_t* A2, float* LSE, int b, u32x4 (&pf)[12], int cunit) {
    attn_issue(Z, b, X.rank, X.tid, pf);
#pragma unroll 1
    for (int u = X.rank; u < 96; u += 32) {
        bf16x8 qr[4];
        attn_issue_q(Z, b, u, X.wave, X.lane, qr);
        attn_stage_write(X.lds, X.tid, pf);
        __syncthreads();
        attn_compute(Z, A2, LSE, b, u, u + 32, X.lds, X.tid, X.wave, X.lane, pf, qr, cunit);
        __syncthreads();
    }
}

__device__ __forceinline__ void attn_sample_unit3(const bf16_t* Z, const float* const* in, bf16_t* A2, int layer, int unit, LAS unsigned char* wl, int lane) {
    const int b = unit >> 2, hs = unit & 3;
    const size_t m = (size_t)MP + b;
    const bf16_t* zr = Z + m * ZN;
    LAS float* sc = (LAS float*)wl;
    const int sub = lane >> 4, e = lane & 15;
    f32x4 og[3]; float lse[3];
#pragma unroll
    for (int g = 0; g < 3; ++g) {
        const int h = g * 4 + hs; const int dsh = 2 * g, d = 1 << dsh, W = 128 << dsh;
        const float* cK = in[2 + 2 * g] + ((size_t)(layer * 32 + b) * W) * 256 + hs * 64;
        const float* cV = in[3 + 2 * g] + ((size_t)(layer * 32 + b) * W) * 256 + hs * 64;
        const unsigned voff = (unsigned)(((3 - sub) * d) * 256 + 4 * e) * 4u;
        const size_t rstep = (size_t)(4 * d) * 256 * 4;
        const char* kb = (const char*)(cK + (size_t)(W - 4 * d) * 256);
        const char* vb = (const char*)(cV + (size_t)(W - 4 * d) * 256);
        f32x4 q4; { const u32x2 qq = *(const u32x2*)(zr + ZC_Q + h * 64 + 4 * e); q4 = (f32x4){bf_lo(qq.x), bf_hi(qq.x), bf_lo(qq.y), bf_hi(qq.y)}; }
        f32x4 kn4; { const u32x2 kk = *(const u32x2*)(zr + ZC_K + h * 64 + 4 * e); kn4 = (f32x4){bf_lo(kk.x), bf_hi(kk.x), bf_lo(kk.y), bf_hi(kk.y)}; }
        f32x4 vn4; { const u32x2 vv = *(const u32x2*)(zr + ZC_V + h * 64 + 4 * e); vn4 = (f32x4){bf_lo(vv.x), bf_hi(vv.x), bf_lo(vv.y), bf_hi(vv.y)}; }
        float pr[32];
        {
            f32x4 k4[32];
#pragma unroll
            for (int it = 0; it < 32; ++it) k4[it] = *(const f32x4*)(kb - (size_t)it * rstep + voff);
            __builtin_amdgcn_sched_barrier(0);
#pragma unroll
            for (int it = 0; it < 32; ++it) pr[it] = (q4.x * k4[it].x + q4.y * k4[it].y) + (q4.z * k4[it].z + q4.w * k4[it].w);
        }
        f32x4 v4[32];
#pragma unroll
        for (int it = 0; it < 32; ++it) v4[it] = *(const f32x4*)(vb - (size_t)it * rstep + voff);
        asm volatile("" ::: "memory"); __builtin_amdgcn_sched_barrier(0);
#pragma unroll
        for (int s = 0; s < 4; ++s) {
            const int half = 16 >> s; const unsigned msk = 0u - (unsigned)((lane >> s) & 1);
#pragma unroll
            for (int i = 0; i < half; ++i) { const unsigned ua = __float_as_uint(pr[i]), ub = __float_as_uint(pr[i + half]);
                const float send = __uint_as_float((ua & msk) | (ub & ~msk)); const float keep = __uint_as_float((ub & msk) | (ua & ~msk)); pr[i] = keep + __shfl_xor(send, 1 << s); }
        }
        { const int it0 = 16 * (e & 1) + 8 * ((e >> 1) & 1) + 4 * ((e >> 2) & 1) + 2 * ((e >> 3) & 1);
          sc[4 * it0 + sub + 1] = pr[0]; sc[4 * (it0 + 1) + sub + 1] = pr[1]; }
        { float p0 = (q4.x * kn4.x + q4.y * kn4.y) + (q4.z * kn4.z + q4.w * kn4.w);
          p0 += __shfl_xor(p0, 1); p0 += __shfl_xor(p0, 2); p0 += __shfl_xor(p0, 4); p0 += __shfl_xor(p0, 8); if (lane == 0) sc[0] = p0; }
        LDS_WAIT();
        const float sa = sc[lane], sb = sc[lane + 64], scc = (lane == 0) ? sc[128] : -INFINITY;
        const float mx = wave_max(fmaxf(fmaxf(sa, sb), scc));
        const float pa = __builtin_amdgcn_exp2f(sa - mx), pb = __builtin_amdgcn_exp2f(sb - mx), pc = __builtin_amdgcn_exp2f(scc - mx);
        const float l = wave_sum(pa + pb + pc);
        LDS_WAIT();
        sc[lane] = pa; sc[lane + 64] = pb; if (lane == 0) sc[128] = pc;
        LDS_WAIT();
        f32x4 acc = {0.f, 0.f, 0.f, 0.f};
#pragma unroll
        for (int it = 0; it < 32; ++it) { const float p = sc[4 * it + sub + 1]; acc = acc + v4[it] * p; }
#pragma unroll
        for (int k = 0; k < 4; ++k) { acc[k] += __shfl_xor(acc[k], 16); acc[k] += __shfl_xor(acc[k], 32); }
        { const float p0 = sc[0]; acc = acc + vn4 * p0; }
        og[g] = acc * (1.0f / l);
        lse[g] = (mx + __builtin_amdgcn_logf(l)) * LN2;
        LDS_WAIT();
        asm volatile("" ::: "memory");
    }
    const float lm = fmaxf(lse[0], fmaxf(lse[1], lse[2]));
    const float e0 = __expf(lse[0] - lm), e1 = __expf(lse[1] - lm), e2 = __expf(lse[2] - lm); const float rs = 1.0f / (e0 + e1 + e2);
    const float al[3] = {e0 * rs, e1 * rs, e2 * rs};
    if (sub == 0) {
#pragma unroll
        for (int g = 0; g < 3; ++g) { const int h = g * 4 + hs; const u32x2 ga = *(const u32x2*)(zr + ZC_GA + h * 64 + 4 * e);
            u32x2 w; w.x = cvt_pk_bf16(og[g].x * al[g] * siluf_(bf_lo(ga.x)), og[g].y * al[g] * siluf_(bf_hi(ga.x))); w.y = cvt_pk_bf16(og[g].z * al[g] * siluf_(bf_lo(ga.y)), og[g].w * al[g] * siluf_(bf_hi(ga.y)));
            st_wt64(A2 + m * AW + h * 64 + 4 * e, w); }
    }
}

__device__ __forceinline__ void bfly32(float (&v)[32], int lane) {
#pragma unroll
    for (int s = 0; s < 5; ++s) {
        const int half = 16 >> s; const unsigned msk = 0u - (unsigned)((lane >> s) & 1);
#pragma unroll
        for (int i = 0; i < half; ++i) { const unsigned ua = __float_as_uint(v[i]), ub = __float_as_uint(v[i + half]);
            const float send = __uint_as_float((ua & msk) | (ub & ~msk)); const float keep = __uint_as_float((ub & msk) | (ua & ~msk)); v[i] = keep + __shfl_xor(send, 1 << s); }
    }
    v[0] += __shfl_xor(v[0], 32);
}
__device__ __forceinline__ int bfly_idx(int lane) { return 16 * (lane & 1) + 8 * ((lane >> 1) & 1) + 4 * ((lane >> 2) & 1) + 2 * ((lane >> 3) & 1) + ((lane >> 4) & 1); }

constexpr int CV_U = 0, CV_STAT = 98304, CV_FIN = CV_STAT + 8 * 32 * 4, CV_W = 100352;
static_assert(CV_W + 8 * 768 * 8 <= LDSCTL_OFF, "conv LDS map");
__device__ __forceinline__ void conv_issue(const bf16_t* Z, int unit, int tid, u32x4 (&ra)[12]) {
    const int b = unit >> 6, s0 = (unit & 63) * 32;
#pragma unroll
    for (int q = 0; q < 12; ++q) { const int ci = tid + 512 * q; const int lr = ci / 96, ch = ci - lr * 96; const int s = s0 - 30 + lr;
        if (ci < 62 * 96 && s >= 0) ra[q] = *(const u32x4*)(Z + ((size_t)b * 2048 + s) * ZN + zc_ca(ch * 8));
        else ra[q] = (u32x4){0u, 0u, 0u, 0u}; }
    __builtin_amdgcn_sched_barrier(0);
}
__device__ __forceinline__ void conv_prompt_wg(Ctx& X, const bf16_t* Z, bf16_t* C2, int layer, int unit0, u32x4 (&ra)[12]) {
    const int tid = X.tid, lane = X.lane;
    const float* cwt = (const float*)(X.ws + WS_CWT) + (size_t)layer * 768 * 32;
    const float* lg = X.in[14] + (size_t)layer * CW; const float* lb = X.in[15] + (size_t)layer * CW;
    LAS bf16_t* U = (LAS bf16_t*)(X.lds + CV_U);
    const int cidx = tid & 255, th = tid >> 8;
    { LAS unsigned char* Wl = X.lds + CV_W;
#pragma unroll
      for (int h = 0; h < 2; ++h) {
        f32x4 wt[6];
#pragma unroll
        for (int k = 0; k < 6; ++k) wt[k] = *(const f32x4*)(cwt + (size_t)(tid + 512 * (6 * h + k)) * 4);
        __builtin_amdgcn_sched_barrier(0);
#pragma unroll
        for (int k = 0; k < 6; ++k) { const int idx = tid + 512 * (6 * h + k), c = idx >> 3, g = idx & 7; u32x2 w; w.x = cvt_pk_bf16(wt[k].x, wt[k].y); w.y = cvt_pk_bf16(wt[k].z, wt[k].w); *(LAS u32x2*)(Wl + (g * 768 + c) * 8) = w; }
        __builtin_amdgcn_sched_barrier(0);
      } }
#pragma unroll
    for (int iter = 0; iter < 2; ++iter) {
        const int unit = unit0 + 32 * iter; const int b = unit >> 6, s0 = (unit & 63) * 32;
        u32x4 gcv[6];
#pragma unroll
        for (int q = 0; q < 6; ++q) { const int ci = tid + 512 * q; const int tl = ci / 96, ch = ci - tl * 96; const size_t m = (size_t)b * 2048 + s0 + tl; gcv[q] = __builtin_nontemporal_load((const u32x4*)(Z + m * ZN + ZC_GC + ch * 8)); }
#pragma unroll
        for (int q = 0; q < 12; ++q) { const int ci = tid + 512 * q; const int lr = ci / 96, ch = ci - lr * 96;
            if (ci < 62 * 96) *(LAS u32x4*)(U + lr * 768 + ch * 8) = ra[q]; }
        __syncthreads();
        float cd[3][16];
#pragma unroll
        for (int k = 0; k < 3; ++k) {
            const int c = cidx + 256 * k;
            u32x2 wq[8];
            { const LAS unsigned char* Wl = X.lds + CV_W + c * 8;
#pragma unroll
              for (int g = 0; g < 8; ++g) wq[g] = *(const LAS u32x2*)(Wl + g * 768 * 8); }
            float uu[46];
#pragma unroll
            for (int j = 0; j < 46; ++j) uu[j] = bf1(U[(th * 16 + j) * 768 + c]);
#pragma unroll
            for (int t = 0; t < 16; ++t) cd[k][t] = 0.f;
#pragma unroll
            for (int i = 0; i < 31; ++i) {
                const unsigned wp = (i & 2) ? wq[i >> 2].y : wq[i >> 2].x; const float w = (i & 1) ? bf_hi(wp) : bf_lo(wp);
#pragma unroll
                for (int t = 0; t < 16; ++t) cd[k][t] += uu[t + i] * w; }
            asm volatile("" ::: "memory"); __builtin_amdgcn_sched_barrier(0);
        }
        float st[32];
#pragma unroll
        for (int t = 0; t < 16; ++t) { st[2 * t] = cd[0][t] + cd[1][t] + cd[2][t]; st[2 * t + 1] = cd[0][t] * cd[0][t] + cd[1][t] * cd[1][t] + cd[2][t] * cd[2][t]; }
        bfly32(st, lane);
        LAS float* part = (LAS float*)(X.lds + CV_STAT);
        LAS float* fin = (LAS float*)(X.lds + CV_FIN);
        if (lane < 32) part[X.wave * 32 + bfly_idx(lane)] = st[0];
        __syncthreads();
        if (iter == 0) conv_issue(Z, unit0 + 32, tid, ra);
        if (tid < 64) {
            const int hf = tid >> 5, idx = tid & 31;
            const float tot = part[(hf * 4 + 0) * 32 + idx] + part[(hf * 4 + 1) * 32 + idx] + part[(hf * 4 + 2) * 32 + idx] + part[(hf * 4 + 3) * 32 + idx];
            const float oth = __shfl_xor(tot, 1);
            const float s1 = (idx & 1) ? oth : tot, s2 = (idx & 1) ? tot : oth;
            float inv768 = 1.f / 768.f; asm volatile("" : "+v"(inv768));
            const float mean = s1 * inv768; const float var = fmaxf(s2 * inv768 - mean * mean, 0.f);
            fin[hf * 32 + idx] = (idx & 1) ? (1.0f / sqrtf(var + LN_EPS)) : mean;
        }
        __syncthreads();
        LAS bf16_t* Y = (LAS bf16_t*)(X.lds + CV_U);
#pragma unroll
        for (int k = 0; k < 3; ++k) {
            const int c = cidx + 256 * k; const float gg = lg[c], bb = lb[c];
#pragma unroll
            for (int t = 0; t < 16; ++t) {
                const float mean = fin[th * 32 + 2 * t], rstd = fin[th * 32 + 2 * t + 1];
                const float y = (cd[k][t] - mean) * rstd * gg + bb;
                Y[(th * 16 + t) * 768 + c] = (bf16_t)(cvt_pk_bf16(siluf_(y), 0.f) & 0xffffu);
            }
        }
        __syncthreads();
#pragma unroll
        for (int q = 0; q < 6; ++q) {
            const int ci = tid + 512 * q;
            const int tl = ci / 96, ch = ci - tl * 96; const size_t m = (size_t)b * 2048 + s0 + tl;
            const u32x4 y = *(const LAS u32x4*)(Y + tl * 768 + ch * 8); const u32x4 gc = gcv[q];
            u32x4 w;
            w.x = cvt_pk_bf16(bf_lo(y.x) * siluf_(bf_lo(gc.x)), bf_hi(y.x) * siluf_(bf_hi(gc.x))); w.y = cvt_pk_bf16(bf_lo(y.y) * siluf_(bf_lo(gc.y)), bf_hi(y.y) * siluf_(bf_hi(gc.y)));
            w.z = cvt_pk_bf16(bf_lo(y.z) * siluf_(bf_lo(gc.z)), bf_hi(y.z) * siluf_(bf_hi(gc.z))); w.w = cvt_pk_bf16(bf_lo(y.w) * siluf_(bf_lo(gc.w)), bf_hi(y.w) * siluf_(bf_hi(gc.w)));
            *(u32x4*)(C2 + m * CW + ch * 8) = w;
        }
        __syncthreads();
    }
}

__device__ __forceinline__ void conv_sample_pair(Ctx& X, const bf16_t* Z, bf16_t* C2, int layer, int b0) {
    const float* cwt = (const float*)(X.ws + WS_CWT) + (size_t)layer * 768 * 32;
    const float* lg = X.in[14] + (size_t)layer * CW; const float* lb = X.in[15] + (size_t)layer * CW;
    const int half = X.tid >> 8, ct = X.tid & 255; const int b = b0 + half * NSVC; const bool act = b < DEC_BATCH; const int bb = act ? b : b0;
    const char* stt = (const char*)(X.in[8] + ((size_t)(layer * 32 + bb) * 30) * 768);
    char* sco = (char*)(X.out + O_SC + ((size_t)(layer * 32 + bb) * 30) * 768);
    const size_t m = (size_t)MP + bb; const bf16_t* zr = Z + m * ZN;
    LAS float* red = (LAS float*)(X.lds + CV_STAT);
    float cd[3]; float s1 = 0.f, s2 = 0.f;
    bf16_t zca[3], zcb[3], zgc[3]; f32x4 w4[3][8]; float sv[3][30], gl[3], bl[3];
#pragma unroll
    for (int k = 0; k < 3; ++k) { const int c = ct + 256 * k; const unsigned vo = (unsigned)c * 4u;
        zca[k] = zr[zc_ca(c)]; zcb[k] = zr[zc_ca(c) + 128]; zgc[k] = zr[ZC_GC + c]; gl[k] = lg[c]; bl[k] = lb[c];
        const f32x4* wp = (const f32x4*)(cwt + (size_t)c * 32);
#pragma unroll
        for (int i = 0; i < 8; ++i) w4[k][i] = wp[i];
#pragma unroll
        for (int i = 0; i < 30; ++i) sv[k][i] = *(const float*)(stt + (size_t)i * 3072 + vo); }
    __builtin_amdgcn_sched_barrier(0);
#pragma unroll
    for (int k = 0; k < 3; ++k) { const int c = ct + 256 * k; const unsigned vo = (unsigned)c * 4u;
        const float un = bf1(zca[k]) * sigmoidf_(bf1(zcb[k]));
        float a = un * w4[k][7].z;
#pragma unroll
        for (int i = 0; i < 30; ++i) { a += sv[k][i] * w4[k][i >> 2][i & 3]; if (act && i >= 1) *(float*)(sco + (size_t)(i - 1) * 3072 + vo) = sv[k][i]; }
        if (act) *(float*)(sco + (size_t)29 * 3072 + vo) = un;
        cd[k] = a; s1 += a; s2 += a * a; }
    s1 = wave_sum(s1); s2 = wave_sum(s2);
    if (X.lane == 0) { red[X.wave * 2] = s1; red[X.wave * 2 + 1] = s2; }
    __syncthreads();
    const int w0 = half * 4;
    const float t1 = red[2 * w0] + red[2 * w0 + 2] + red[2 * w0 + 4] + red[2 * w0 + 6], t2 = red[2 * w0 + 1] + red[2 * w0 + 3] + red[2 * w0 + 5] + red[2 * w0 + 7];
    const float mean = t1 * (1.f / 768.f); const float var = fmaxf(t2 * (1.f / 768.f) - mean * mean, 0.f); const float rstd = 1.0f / sqrtf(var + LN_EPS);
    if (act) {
#pragma unroll
        for (int k = 0; k < 3; ++k) { const int c = ct + 256 * k;
            const float y = (cd[k] - mean) * rstd * gl[k] + bl[k];
            const float o = siluf_(y) * siluf_(bf1(zgc[k]));
            st_wt16(C2 + m * CW + c, (bf16_t)(cvt_pk_bf16(o, 0.f) & 0xffffu)); }
    }
    __syncthreads();
}

__device__ __forceinline__ void p2b_fix(Ctx& X) {
    const bf16_t* Z = (const bf16_t*)(X.ws + WS_Z); bf16_t* A2 = (bf16_t*)(X.ws + WS_A2); const float* LSE = (const float*)(X.ws + WS_LSE);
    const int NT = 32 * 512; const int ibase = X.xcc * (SEQ * 96), iend = ibase + SEQ * 96;
    for (int i0 = ibase + X.rank * 512 + X.tid; i0 < iend; i0 += 6 * NT) {
        u32x4 av[6], gv[6]; float l0[6], l1[6], l2[6];
#pragma unroll
        for (int u = 0; u < 6; ++u) { const int i = i0 + u * NT; const int ii = i < iend ? i : i0; const int m = ii / 96, q = ii - m * 96; const int hs = (q >> 3) & 3;
            av[u] = *(const u32x4*)(A2 + (size_t)m * AW + q * 8); gv[u] = __builtin_nontemporal_load((const u32x4*)(Z + (size_t)m * ZN + ZC_GA + q * 8));
            { const f32x4 L4 = *(const f32x4*)(LSE + ((size_t)m * 4 + hs) * 4); l0[u] = L4.x; l1[u] = L4.y; l2[u] = L4.z; } }
        __builtin_amdgcn_sched_barrier(0);
#pragma unroll
        for (int u = 0; u < 6; ++u) { const int i = i0 + u * NT; if (i < iend) { const int m = i / 96, q = i - m * 96; const int g = q >> 5;
            const float mx = fmaxf(l0[u], fmaxf(l1[u], l2[u]));
            const float e0 = __expf(l0[u] - mx), e1 = __expf(l1[u] - mx), e2 = __expf(l2[u] - mx);
            const float al = (g == 0 ? e0 : (g == 1 ? e1 : e2)) * __builtin_amdgcn_rcpf(e0 + e1 + e2);
            const u32x4 a = av[u], ga = gv[u]; u32x4 w;
            w.x = cvt_pk_bf16(bf_lo(a.x) * al * siluf_(bf_lo(ga.x)), bf_hi(a.x) * al * siluf_(bf_hi(ga.x))); w.y = cvt_pk_bf16(bf_lo(a.y) * al * siluf_(bf_lo(ga.y)), bf_hi(a.y) * al * siluf_(bf_hi(ga.y)));
            w.z = cvt_pk_bf16(bf_lo(a.z) * al * siluf_(bf_lo(ga.z)), bf_hi(a.z) * al * siluf_(bf_hi(ga.z))); w.w = cvt_pk_bf16(bf_lo(a.w) * al * siluf_(bf_lo(ga.w)), bf_hi(a.w) * al * siluf_(bf_hi(ga.w)));
            *(u32x4*)(A2 + (size_t)m * AW + q * 8) = w; } }
    }
}

__device__ __forceinline__ void p2_mix(Ctx& X, int layer) {
    const bf16_t* Z = (const bf16_t*)(X.ws + WS_Z); bf16_t* A2 = (bf16_t*)(X.ws + WS_A2); bf16_t* C2 = (bf16_t*)(X.ws + WS_C2); float* LSE = (float*)(X.ws + WS_LSE);
    constexpr int U_PA = 768, U_PC = 512;
    LAS unsigned char* wl = X.lds + X.wave * 12288;
    u32x4 pf[12]; const int cunit0 = X.xcc * (U_PC / 8) + X.rank;
    attn_prompt_wg(X, Z, A2, LSE, X.xcc, pf, cunit0);
    unsigned* xa = (unsigned*)(X.ws + WS_CTL) + CW_XA + 64 * X.xcc;
    asm volatile("s_waitcnt vmcnt(0)" ::: "memory");
    __syncthreads();
    if (X.tid == 0) xb_add(xa, 1u);
    conv_prompt_wg(X, Z, C2, layer, cunit0, pf);
    asm volatile("s_waitcnt vmcnt(0)" ::: "memory");
    __syncthreads();
    if (X.tid == 0) xb_add((unsigned*)(X.ws + WS_CTL) + CW_XC + 64 * X.xcc, 1u);
    if (X.tid == 0) { unsigned sp = 0; while (xb_ld(xa) < 32u * (unsigned)(layer + 1)) { __builtin_amdgcn_s_sleep(1); if (++sp > (1u << 22)) break; }
        __builtin_amdgcn_fence(__ATOMIC_ACQUIRE, "agent"); asm volatile("s_waitcnt vmcnt(0)" ::: "memory"); }
    __syncthreads();
    p2b_fix(X);
    asm volatile("s_waitcnt vmcnt(0)" ::: "memory");
    __syncthreads();
    if (X.tid == 0) xb_add((unsigned*)(X.ws + WS_CTL) + CW_XP + 64 * X.xcc, 1u);
}

template <bool WT>
__device__ __forceinline__ void p5_row(Ctx& X, int layer, int m) {
    const float* R = (const float*)(X.ws + WS_R); bf16_t* H = (bf16_t*)(X.ws + WS_H);
    const float* gpost = X.in[17] + (size_t)layer * 1024; const float* gpre = X.in[16] + (size_t)(layer + 1 < DEPTH ? layer + 1 : 0) * 1024;
    const float* xrow = (layer == 0) ? ((m < MP) ? X.in[0] + (size_t)m * 1024 : X.in[1] + (size_t)(m - MP) * 1024) : X.out + (size_t)m * 1024;
    float* yrow = X.out + (size_t)m * 1024;
    const f32x4* rr = (const f32x4*)(R + (size_t)m * 1024) + X.lane; const f32x4* xr = (const f32x4*)xrow + X.lane;
    f32x4 rv[4], xv[4], gp[4], gq[4]; float s = 0.f;
#pragma unroll
    for (int j = 0; j < 4; ++j) { rv[j] = rr[64 * j]; xv[j] = xr[64 * j]; gp[j] = ((const f32x4*)gpost)[X.lane + 64 * j]; gq[j] = ((const f32x4*)gpre)[X.lane + 64 * j]; }
    __builtin_amdgcn_sched_barrier(0);
#pragma unroll
    for (int j = 0; j < 4; ++j) s += (rv[j].x * rv[j].x + rv[j].y * rv[j].y) + (rv[j].z * rv[j].z + rv[j].w * rv[j].w);
    const float rs = 1.0f / sqrtf(wave_sum(s) * (1.f / 1024.f) + RMS_EPS);
    float s2 = 0.f;
#pragma unroll
    for (int j = 0; j < 4; ++j) { xv[j] = xv[j] + (rv[j] * rs) * gp[j]; if (WT) st16f_wt((f32x4*)yrow + X.lane + 64 * j, xv[j]); else ((f32x4*)yrow)[X.lane + 64 * j] = xv[j];
        s2 += (xv[j].x * xv[j].x + xv[j].y * xv[j].y) + (xv[j].z * xv[j].z + xv[j].w * xv[j].w); }
    if (layer + 1 < DEPTH) {
        const float rs2 = 1.0f / sqrtf(wave_sum(s2) * (1.f / 1024.f) + RMS_EPS);
        u32x2* o8 = (u32x2*)(H + (size_t)m * 1024) + X.lane;
#pragma unroll
        for (int j = 0; j < 4; ++j) { const f32x4 gg = gq[j]; u32x2 w; w.x = cvt_pk_bf16(xv[j].x * rs2 * gg.x, xv[j].y * rs2 * gg.y); w.y = cvt_pk_bf16(xv[j].z * rs2 * gg.z, xv[j].w * rs2 * gg.w); if (WT) st_wt64(o8 + 64 * j, w); else o8[64 * j] = w; }
    }
}

template <int K>
__device__ __forceinline__ f32x16 skinny_block(const bf16_t* A, int lda, const bf16_t* Bt, int lane) {
    const int r32 = lane & 31, hi = lane >> 5;
    const bf16_t* ap = A + (size_t)r32 * lda + hi * 8; const bf16_t* bp = Bt + (size_t)r32 * K + hi * 8;
    f32x16 acc = {};
    bf16x8 a0[8], b0[8], a1[8], b1[8];
#define SK_LOAD(a, b, k0) _Pragma("unroll") for (int j = 0; j < 8; ++j) { a[j] = *(const bf16x8*)(ap + (k0) + 16 * j); b[j] = *(const bf16x8*)(bp + (k0) + 16 * j); } __builtin_amdgcn_sched_barrier(0)
#define SK_MMA(a, b) _Pragma("unroll") for (int j = 0; j < 8; ++j) acc = __builtin_amdgcn_mfma_f32_32x32x16_bf16(a[j], b[j], acc, 0, 0, 0); __builtin_amdgcn_sched_barrier(0)
    SK_LOAD(a0, b0, 0);
#pragma unroll 1
    for (int k0 = 0; k0 < K; k0 += 256) {
        SK_LOAD(a1, b1, k0 + 128);
        SK_MMA(a0, b0);
        if (k0 + 256 < K) { SK_LOAD(a0, b0, k0 + 256); }
        SK_MMA(a1, b1);
    }
#undef SK_LOAD
#undef SK_MMA
    return acc;
}
__device__ __forceinline__ void svc_barrier(Ctx& X, unsigned target) {
    unsigned* ctr = (unsigned*)(X.ws + WS_CTL) + CW_SVC;
    asm volatile("s_waitcnt vmcnt(0)" ::: "memory");
    __syncthreads();
    if (X.tid == 0) {
        xb_add(ctr, 1u);
        unsigned sp = 0; while (xb_ld(ctr) < target) { __builtin_amdgcn_s_sleep(1); if (++sp > (1u << 22)) break; }
        __builtin_amdgcn_fence(__ATOMIC_ACQUIRE, "agent");
        asm volatile("s_waitcnt vmcnt(0)" ::: "memory");
    }
    __syncthreads();
}
__device__ __forceinline__ void svc_gemm1(Ctx& X, int layer, int sw) {
    const bf16_t* Hs = (const bf16_t*)(X.ws + WS_H) + (size_t)MP * 1024;
    const bf16_t* Wt = (const bf16_t*)(X.ws + WS_WIN + layer * SZ_WIN1);
    bf16_t* Z = (bf16_t*)(X.ws + WS_Z); const float* rope = (const float*)(X.ws + WS_ROPE) + 2048 * 16;
    const int r32 = X.lane & 31, hi = X.lane >> 5;
    for (int cb = sw; cb < ZN / 32; cb += NSVC * 8) {
        const f32x16 acc = skinny_block<1024>(Hs, 1024, Wt + (size_t)cb * 32 * 1024, X.lane);
        const int n = cb * 32 + r32, hc = n & 63;
        const bool ropeblk = (cb * 32 < 1536) && (((cb * 32) & 63) == 0);
        const float cs = rope[hc & 7], sn = rope[8 + (hc & 7)], sgn = (hc < 8) ? -1.f : 1.f;
        const float qs = (n < 768) ? QSCALE : 1.f;
        float* st = nullptr; int Wg = 0;
        if (n >= 768 && n < 2304) { const bool isv = n >= 1536; const int nn = n - (isv ? 1536 : 768); const int g = nn >> 8; Wg = 128 << (2 * g);
            const size_t base = isv ? (g == 0 ? O_SV0 : g == 1 ? O_SV1 : O_SV2) : (g == 0 ? O_SK0 : g == 1 ? O_SK1 : O_SK2); st = X.out + base + (size_t)(Wg - 1) * 256 + (nn & 255); }
#pragma unroll
        for (int r = 0; r < 16; ++r) { const int m = crow(r, hi); float v = acc[r];
            if (ropeblk) { const float p = __shfl_xor(v, 8); if (hc < 16) v = v * cs + sgn * p * sn; }
            v *= qs;
            st_wt16(Z + ((size_t)MP + m) * ZN + n, (bf16_t)(cvt_pk_bf16(v, 0.f) & 0xffffu));
            if (st) st[(size_t)(layer * 32 + m) * Wg * 256] = v; }
    }
}
template <int K, int KS>
__device__ __forceinline__ void skinny_part2(const bf16_t* A, int lda, const bf16_t* Bt0, const bf16_t* Bt1, int wave, int lane, f32x16& acc0, f32x16& acc1) {
    const int r32 = lane & 31, hi = lane >> 5;
    const bf16_t* ap = A + (size_t)r32 * lda + wave * KS + hi * 8; const bf16_t* bp0 = Bt0 + (size_t)r32 * K + wave * KS + hi * 8; const bf16_t* bp1 = Bt1 + (size_t)r32 * K + wave * KS + hi * 8;
    bf16x8 a[KS / 16], b0[KS / 16], b1[KS / 16];
#pragma unroll
    for (int j = 0; j < KS / 16; ++j) { a[j] = *(const bf16x8*)(ap + 16 * j); b0[j] = *(const bf16x8*)(bp0 + 16 * j); b1[j] = *(const bf16x8*)(bp1 + 16 * j); }
    __builtin_amdgcn_sched_barrier(0);
#pragma unroll
    for (int j = 0; j < KS / 16; ++j) { acc0 = __builtin_amdgcn_mfma_f32_32x32x16_bf16(a[j], b0[j], acc0, 0, 0, 0); acc1 = __builtin_amdgcn_mfma_f32_32x32x16_bf16(a[j], b1[j], acc1, 0, 0, 0); }
}
__device__ __forceinline__ void svc_gemm2(Ctx& X, int layer, int sv) {
    const bf16_t* Z = (const bf16_t*)(X.ws + WS_Z); bf16_t* MG = (bf16_t*)(X.ws + WS_MG);
    const int r32 = X.lane & 31, hi = X.lane >> 5;
    LAS float* red = (LAS float*)X.lds;
    const int cb0 = sv, cb1 = (sv + NSVC < 32) ? sv + NSVC : sv;
    const bf16_t* Wao = (const bf16_t*)(X.ws + WS_WAO + layer * SZ_WAO1); const bf16_t* Wco = (const bf16_t*)(X.ws + WS_WCO + layer * SZ_WAO1);
    f32x16 ya0 = {}, ya1 = {}, yc0 = {}, yc1 = {};
    bf16_t gma[2][2], gmc[2][2];
#pragma unroll
    for (int q = 0; q < 2; ++q) { const size_t m = (size_t)MP + crow(2 * X.wave + q, hi);
        gma[q][0] = Z[m * ZN + ZC_MA + cb0 * 32 + r32]; gmc[q][0] = Z[m * ZN + ZC_MC + cb0 * 32 + r32]; gma[q][1] = Z[m * ZN + ZC_MA + cb1 * 32 + r32]; gmc[q][1] = Z[m * ZN + ZC_MC + cb1 * 32 + r32]; }
    skinny_part2<768, 96>((const bf16_t*)(X.ws + WS_A2) + (size_t)MP * 768, 768, Wao + (size_t)cb0 * 32 * 768, Wao + (size_t)cb1 * 32 * 768, X.wave, X.lane, ya0, ya1);
    skinny_part2<768, 96>((const bf16_t*)(X.ws + WS_C2) + (size_t)MP * 768, 768, Wco + (size_t)cb0 * 32 * 768, Wco + (size_t)cb1 * 32 * 768, X.wave, X.lane, yc0, yc1);
#pragma unroll
    for (int r = 0; r < 16; ++r) { red[((0 * 8 + X.wave) * 16 + r) * 64 + X.lane] = ya0[r]; red[((1 * 8 + X.wave) * 16 + r) * 64 + X.lane] = yc0[r];
                                   red[((2 * 8 + X.wave) * 16 + r) * 64 + X.lane] = ya1[r]; red[((3 * 8 + X.wave) * 16 + r) * 64 + X.lane] = yc1[r]; }
    __syncthreads();
#pragma unroll
    for (int q = 0; q < 2; ++q) { const int r = 2 * X.wave + q; float sa0 = 0.f, sc0 = 0.f, sa1 = 0.f, sc1 = 0.f;
#pragma unroll
        for (int w = 0; w < 8; ++w) { sa0 += red[((0 * 8 + w) * 16 + r) * 64 + X.lane]; sc0 += red[((1 * 8 + w) * 16 + r) * 64 + X.lane]; sa1 += red[((2 * 8 + w) * 16 + r) * 64 + X.lane]; sc1 += red[((3 * 8 + w) * 16 + r) * 64 + X.lane]; }
        const size_t m = (size_t)MP + crow(r, hi);
        const float v0 = sigmoidf_(bf1(gma[q][0])) * sa0 + sigmoidf_(bf1(gmc[q][0])) * sc0, v1 = sigmoidf_(bf1(gma[q][1])) * sa1 + sigmoidf_(bf1(gmc[q][1])) * sc1;
        st_wt16(MG + m * 1024 + cb0 * 32 + r32, (bf16_t)(cvt_pk_bf16(v0, 0.f) & 0xffffu));
        if (cb1 != cb0) st_wt16(MG + m * 1024 + cb1 * 32 + r32, (bf16_t)(cvt_pk_bf16(v1, 0.f) & 0xffffu)); }
    __syncthreads();
}
__device__ __forceinline__ void svc_gemm3(Ctx& X, int layer, int sv) {
    float* R = (float*)(X.ws + WS_R);
    const int r32 = X.lane & 31, hi = X.lane >> 5;
    LAS float* red = (LAS float*)X.lds;
    const int cb0 = sv, cb1 = (sv + NSVC < 32) ? sv + NSVC : sv;
    const bf16_t* Wo = (const bf16_t*)(X.ws + WS_WO + layer * SZ_WO1);
    f32x16 r0 = {}, r1 = {};
    skinny_part2<1024, 128>((const bf16_t*)(X.ws + WS_MG) + (size_t)MP * 1024, 1024, Wo + (size_t)cb0 * 32 * 1024, Wo + (size_t)cb1 * 32 * 1024, X.wave, X.lane, r0, r1);
#pragma unroll
    for (int r = 0; r < 16; ++r) { red[((0 * 8 + X.wave) * 16 + r) * 64 + X.lane] = r0[r]; red[((1 * 8 + X.wave) * 16 + r) * 64 + X.lane] = r1[r]; }
    __syncthreads();
#pragma unroll
    for (int q = 0; q < 2; ++q) { const int r = 2 * X.wave + q; float s0 = 0.f, s1 = 0.f;
#pragma unroll
        for (int w = 0; w < 8; ++w) { s0 += red[((0 * 8 + w) * 16 + r) * 64 + X.lane]; s1 += red[((1 * 8 + w) * 16 + r) * 64 + X.lane]; }
        st_wt32(R + ((size_t)MP + crow(r, hi)) * 1024 + cb0 * 32 + r32, s0);
        if (cb1 != cb0) st_wt32(R + ((size_t)MP + crow(r, hi)) * 1024 + cb1 * 32 + r32, s1); }
    __syncthreads();
}
__device__ __forceinline__ void service_layer(Ctx& X, int layer) {
    const int sv = X.vb - NG1, sw = sv * 8 + X.wave;
    const unsigned e0 = (unsigned)layer * 5u * NSVC;
    const bf16_t* Z = (const bf16_t*)(X.ws + WS_Z); bf16_t* A2 = (bf16_t*)(X.ws + WS_A2); bf16_t* C2 = (bf16_t*)(X.ws + WS_C2);
    svc_gemm1(X, layer, sw);
    svc_barrier(X, e0 + 1u * NSVC);
    if (sw < 128) attn_sample_unit3(Z, X.in, A2, layer, sw, X.lds + X.wave * 12288, X.lane);
    __syncthreads();
    conv_sample_pair(X, Z, C2, layer, sv);
    svc_barrier(X, e0 + 2u * NSVC);
    svc_gemm2(X, layer, sv);
    svc_barrier(X, e0 + 3u * NSVC);
    svc_gemm3(X, layer, sv);
    svc_barrier(X, e0 + 4u * NSVC);
    if (sw < DEC_BATCH) p5_row<true>(X, layer, MP + sw);
    svc_barrier(X, e0 + 5u * NSVC);
}

constexpr int N_PHASES = 1 + 4 * DEPTH;
__global__ void __launch_bounds__(NWAVES * 64, 2) hybrid_fwd(Args args) {
    extern __shared__ __attribute__((aligned(16))) unsigned char lds_raw[];
    Ctx X;
    X.lds = (LAS unsigned char*)lds_raw;
    X.tid = threadIdx.x; X.lane = X.tid & 63; X.wave = __builtin_amdgcn_readfirstlane(X.tid >> 6);
    X.G = gridDim.x;
    X.in = args.in; X.out = args.out; X.ws = args.ws;
    volatile LAS unsigned* MISC = (volatile LAS unsigned*)(X.lds + MISC_OFF);
    for (int u = X.tid; u < (LDS_BYTES - LDSCTL_OFF) / 4; u += NWAVES * 64) ((LAS unsigned*)(X.lds + LDSCTL_OFF))[u] = 0u;
    __syncthreads();
    {
        const unsigned x = xb_xcc_id() & 7u;
        if (X.tid == 0) MISC[16] = xb_add((unsigned*)(X.ws + WS_CTL) + CW_RANK + 64 * x, 1u) & 31u;
        __syncthreads();
        X.xcc = (int)x; X.rank = __builtin_amdgcn_readfirstlane((int)MISC[16]); X.vb = X.rank * 8 + X.xcc; X.vcu = X.xcc * 32 + X.rank;
    }
    const int xcc0 = X.xcc, rank0 = X.rank;
    unsigned* barw = (unsigned*)(X.ws + WS_CTL) + CW_BAR;
    XcdBarrier bar; bar.bar = barw; bar.x = 0; bar.st = nullptr;
    bar = xcd_barrier_post(barw, MISC + 8);
    const int wave0 = X.wave;

    unsigned nxl = 0;
    for (int ph = 0; ph < N_PHASES; ++ph) {
        { GAS unsigned char* w_ = (GAS unsigned char*)args.ws; GAS float* o_ = (GAS float*)args.out; asm volatile("" : "+s"(w_), "+s"(o_)); X.ws = (unsigned char*)w_; X.out = (float*)o_;
          int wv_ = wave0, ln_; asm volatile("" : "+s"(wv_)); asm volatile("v_mbcnt_lo_u32_b32 %0, -1, 0\n\tv_mbcnt_hi_u32_b32 %0, -1, %0" : "=v"(ln_));
          X.tid = wv_ * 64 + ln_; X.lane = ln_; X.wave = wv_;
          int x_ = xcc0, r_ = rank0; asm volatile("" : "+s"(x_), "+s"(r_)); X.xcc = x_; X.rank = r_; X.vb = r_ * 8 + x_; X.vcu = x_ * 32 + r_; }
        if (ph == 0) { p0_prep(X); }
        else {
            const int layer = (ph - 1) / 4, sub = (ph - 1) % 4;
            if (sub == 0) {
                if (X.vb < NG1) {
                    pg8::Sched S; S.init(MP, ZN, 1024, NG1, X.vb, 1, X.ws + WS_H, X.ws + WS_WIN + layer * SZ_WIN1, nullptr, nullptr); S.wgm = 4; S.rev = true;
                    Epi1 E{(bf16_t*)(X.ws + WS_Z), (const float*)(X.ws + WS_ROPE), X.out, layer, X.in, layer * 4, X.vb};
                    pg8::gemm_phase<Epi1, true>(X.lds, 1024, S, E, X.tid);
                } else {
                    service_layer(X, layer);
                }
            } else if (sub == 1) {
                p2_mix(X, layer);
            } else if (sub == 2) {
                pg8::Sched S; S.init(MP, 1024, 768, X.G, X.vb, 2, X.ws + WS_C2, X.ws + WS_WCO + layer * SZ_WAO1, X.ws + WS_A2, X.ws + WS_WAO + layer * SZ_WAO1);
                Epi2 E{(const bf16_t*)(X.ws + WS_Z), (bf16_t*)(X.ws + WS_MG), (unsigned*)(X.ws + WS_CTL) + CW_XC + 64 * X.xcc, (unsigned*)(X.ws + WS_CTL) + CW_XP + 64 * X.xcc, 32u * (unsigned)(layer + 1)};
                pg8::gemm_phase<Epi2, true>(X.lds, 768, S, E, X.tid);
                if (X.tid == 0) xb_add((unsigned*)(X.ws + WS_CTL) + CW_PAN1 + 64 * (8 * X.xcc + (X.rank & 7)), 1u);
            } else if (sub == 3) {
                pg8::Sched S; S.init(MP, 1024, 1024, X.G, X.vb, 1, X.ws + WS_MG, X.ws + WS_WO + layer * SZ_WO1, nullptr, nullptr);
                Epi3F<false> E{X.in[0], X.out, (bf16_t*)(X.ws + WS_H), X.in[17] + (size_t)layer * 1024, X.in[16] + (size_t)(layer + 1 < DEPTH ? layer + 1 : 0) * 1024,
                    (float*)(X.ws + WS_XB1), (float*)(X.ws + WS_XB2), (unsigned*)(X.ws + WS_CTL) + CW_PAN1, (unsigned*)(X.ws + WS_CTL) + CW_PAN2, 4u * (unsigned)(layer + 1), layer + 1 == DEPTH, X.in[16] + (size_t)layer * 1024, (float*)(X.ws + WS_RS)};
                pg8::gemm_phase<Epi3F<false>, false>(X.lds, 1024, S, E, X.tid);
            }
        }
        if (ph + 1 < N_PHASES) {
            if (ph == 0) xcd_barrier(bar);
            else if ((ph - 1) % 4 == 0 || (ph - 1) % 4 == 3) {
                ++nxl; unsigned* xl = (unsigned*)(X.ws + WS_CTL) + CW_XL + 64 * X.xcc;
                xl_arrive(xl);
                { const int bslot = 2 * ((ph - 1) / 4) + ((ph - 1) % 4 == 3 ? 1 : 0); const int pid = (bslot * 256 + X.vb) * 8 + X.wave;
                  const Piece CP = piece_of(X.in, X.out, pid, X.lane); f32x4 cpr[16]; PC_LOAD(cpr, CP, 0, 16) PC_STORE(cpr, CP, 0, 16) }
                xl_wait(xl, 32u * nxl);
            }
        }
    }
}

extern "C" void kernel_launch(void* const* d_in, const int* in_sizes, int n_in, void* d_out, int out_size, void* d_ws, size_t ws_size, hipStream_t stream) {
    static int grid = 0;
    if (grid == 0) {
        if (n_in != 18 || (size_t)out_size != O_END || ws_size < WS_END) { fprintf(stderr, "kernel_launch: unexpected shapes: n_in %d out %d ws %zu (need %zu)\n", n_in, out_size, ws_size, (size_t)WS_END); grid = -1; return; }
        int dev = 0, cus = 0;
        if (hipGetDevice(&dev) != hipSuccess || hipDeviceGetAttribute(&cus, hipDeviceAttributeMultiprocessorCount, dev) != hipSuccess) { grid = -1; return; }
        if (hipFuncSetAttribute((const void*)hybrid_fwd, hipFuncAttributeMaxDynamicSharedMemorySize, LDS_BYTES) != hipSuccess) { fprintf(stderr, "kernel_launch: hipFuncSetAttribute failed\n"); grid = -1; return; }
        int per_cu = 0;
        if (hipOccupancyMaxActiveBlocksPerMultiprocessor(&per_cu, (const void*)hybrid_fwd, NWAVES * 64, LDS_BYTES) != hipSuccess || per_cu < 1) fprintf(stderr, "kernel_launch: occupancy query reports %d\n", per_cu);
        (void)hipGetLastError();
        grid = cus;
        if (grid != NG1 + NSVC) { fprintf(stderr, "kernel_launch: built for %d CUs, device has %d\n", NG1 + NSVC, cus); grid = -1; return; }
    }
    if (grid < 0) return;
    (void)hipMemsetAsync((char*)d_ws + WS_CTL, 0, CTL_ZERO_BYTES, stream);
    Args a{};
    for (int i = 0; i < 18; ++i) a.in[i] = (const float*)d_in[i];
    a.out = (float*)d_out; a.ws = (unsigned char*)d_ws;
    a.ph_lo = 0; a.ph_hi = N_PHASES; a.li = 0;
    hipLaunchKernelGGL(hybrid_fwd, dim3(grid), dim3(NWAVES * 64), LDS_BYTES, stream, a);
}
```

```cpp
#include <hip/hip_runtime.h>
#include <cstdio>
#include <cstdint>

#ifndef MK_N_LAUNCHES
#define MK_N_LAUNCHES 1
#endif

#define LAS __attribute__((address_space(3)))
#define GAS __attribute__((address_space(1)))
typedef unsigned short bf16_t;
typedef short bf16x8 __attribute__((ext_vector_type(8)));
typedef short s16x4 __attribute__((ext_vector_type(4)));
typedef float f32x4 __attribute__((ext_vector_type(4)));
typedef float f32x2 __attribute__((ext_vector_type(2)));
typedef float f32x16 __attribute__((ext_vector_type(16)));
typedef unsigned u32x4 __attribute__((ext_vector_type(4)));
typedef unsigned u32x2 __attribute__((ext_vector_type(2)));

constexpr int D_MODEL = 1024, BATCH = 8, SEQ = 2048, DEPTH = 4, DEC_BATCH = 32;
constexpr int MP = BATCH * SEQ;
constexpr int MR = MP + DEC_BATCH;
constexpr int MPAD = 16640;
constexpr int ZN = 7424;
constexpr int ZC_Q = 0, ZC_K = 768, ZC_V = 1536, ZC_GA = 2304, ZC_CA = 3072, ZC_CB = 3840, ZC_GC = 4608, ZC_MA = 5376, ZC_MC = 6400;
constexpr int AW = 768, CW = 768, CONV_K = 31;
__host__ __device__ __forceinline__ constexpr int zc_ca(int c) { return 3072 + 256 * (c >> 7) + (c & 127); }
constexpr float RMS_EPS = 1e-6f, LN_EPS = 1e-5f;
constexpr float LOG2E = 1.4426950408889634f, LN2 = 0.6931471805599453f;
constexpr float QSCALE = 0.125f * LOG2E;

constexpr size_t O_YP = 0;
constexpr size_t O_YS = O_YP + (size_t)MP * D_MODEL;
constexpr size_t O_PK0 = O_YS + (size_t)DEC_BATCH * D_MODEL;
constexpr size_t SZ_P0 = (size_t)DEPTH * BATCH * 128 * 256, SZ_P1 = (size_t)DEPTH * BATCH * 512 * 256, SZ_P2 = (size_t)DEPTH * BATCH * 2048 * 256;
constexpr size_t O_PV0 = O_PK0 + SZ_P0, O_PK1 = O_PV0 + SZ_P0, O_PV1 = O_PK1 + SZ_P1, O_PK2 = O_PV1 + SZ_P1, O_PV2 = O_PK2 + SZ_P2;
constexpr size_t O_PC = O_PV2 + SZ_P2;
constexpr size_t SZ_PC = (size_t)DEPTH * BATCH * 30 * 768;
constexpr size_t O_SK0 = O_PC + SZ_PC;
constexpr size_t SZ_S0 = (size_t)DEPTH * DEC_BATCH * 128 * 256, SZ_S1 = (size_t)DEPTH * DEC_BATCH * 512 * 256, SZ_S2 = (size_t)DEPTH * DEC_BATCH * 2048 * 256;
constexpr size_t O_SV0 = O_SK0 + SZ_S0, O_SK1 = O_SV0 + SZ_S0, O_SV1 = O_SK1 + SZ_S1, O_SK2 = O_SV1 + SZ_S1, O_SV2 = O_SK2 + SZ_S2;
constexpr size_t O_SC = O_SV2 + SZ_S2;
constexpr size_t SZ_SC = (size_t)DEPTH * DEC_BATCH * 30 * 768;
constexpr size_t O_END = O_SC + SZ_SC;
static_assert(O_END == 240697344ull, "output size");

constexpr size_t MiB = 1u << 20;
constexpr size_t WS_CTL = 0, CTL_ZERO_BYTES = 2 * MiB;
constexpr size_t WS_XB1 = 1 * MiB;
constexpr size_t WS_XB2 = WS_XB1 + (size_t)16384 * 4 * 8;
constexpr size_t WS_ROPE = 2 * MiB;
constexpr size_t WS_WIN = 3 * MiB;
constexpr size_t SZ_WIN1 = (size_t)ZN * 1024 * 2;
constexpr size_t WS_WAO = WS_WIN + 4 * SZ_WIN1;
constexpr size_t SZ_WAO1 = (size_t)1024 * 768 * 2;
constexpr size_t WS_WCO = WS_WAO + 4 * SZ_WAO1;
constexpr size_t WS_WO = WS_WCO + 4 * SZ_WAO1;
constexpr size_t SZ_WO1 = (size_t)1024 * 1024 * 2;
constexpr size_t WS_H = WS_WO + 4 * SZ_WO1;
constexpr size_t WS_Z = WS_H + (size_t)MPAD * 1024 * 2;
constexpr size_t WS_A2 = WS_Z + (size_t)MPAD * ZN * 2;
constexpr size_t WS_C2 = WS_A2 + (size_t)MPAD * 768 * 2;
constexpr size_t WS_MG = WS_C2 + (size_t)MPAD * 768 * 2;
constexpr size_t WS_R = WS_MG + (size_t)MPAD * 1024 * 2;
constexpr size_t WS_LSE = WS_R + (size_t)MPAD * 1024 * 4;
constexpr size_t WS_CWT = WS_LSE + (size_t)MPAD * 16 * 4;
constexpr size_t WS_RS = WS_CWT + (size_t)4 * 768 * 32 * 4;
constexpr size_t WS_END = WS_RS + (size_t)MP * 4;

constexpr int CW_BAR = 4096;
constexpr int CW_SVC = 8192;
constexpr int CW_RANK = 9216;
constexpr int CW_XL = 9728;
constexpr int CW_XC = 19456, CW_XP = 19968;
constexpr int CW_XA = 18432;
constexpr int CW_PAN1 = 10240, CW_PAN2 = 14336;
constexpr int NSVC = 24, NG1 = 232;

constexpr int RING_BYTES = 131072;
constexpr int LDSCTL_OFF = 150528;
constexpr int MISC_OFF = LDSCTL_OFF + 320;
constexpr int LDS_BYTES = LDSCTL_OFF + 1024;
constexpr int NWAVES = 8;

#define RLX_AGENT __ATOMIC_RELAXED, __HIP_MEMORY_SCOPE_AGENT
#define LDS_WAIT() asm volatile("s_waitcnt lgkmcnt(0)" ::: "memory")
#define VM_WAIT() asm volatile("s_waitcnt vmcnt(0)" ::: "memory")

__device__ __forceinline__ unsigned cvt_pk_bf16(float lo, float hi) { unsigned r; asm volatile("v_cvt_pk_bf16_f32 %0, %1, %2" : "=v"(r) : "v"(lo), "v"(hi)); return r; }
__device__ __forceinline__ void st_wt16(bf16_t* p, bf16_t v) { __hip_atomic_store(p, v, __ATOMIC_RELAXED, __HIP_MEMORY_SCOPE_AGENT); }
__device__ __forceinline__ void st_wt32(float* p, float v) { __hip_atomic_store((unsigned*)p, __float_as_uint(v), __ATOMIC_RELAXED, __HIP_MEMORY_SCOPE_AGENT); }
__device__ __forceinline__ void st_wt64(void* p, u32x2 v) { __hip_atomic_store((unsigned long long*)p, ((unsigned long long)v.y << 32) | v.x, __ATOMIC_RELAXED, __HIP_MEMORY_SCOPE_AGENT); }
__device__ __forceinline__ void st16f_wt(void* p, f32x4 v) { asm volatile("global_store_dwordx4 %0, %1, off sc1\n\ts_nop 1" :: "v"((GAS void*)p), "v"(v) : "memory"); }
__device__ __forceinline__ float bf_lo(unsigned u) { return __uint_as_float(u << 16); }
__device__ __forceinline__ float bf_hi(unsigned u) { return __uint_as_float(u & 0xffff0000u); }
__device__ __forceinline__ float bf1(bf16_t u) { return __uint_as_float(((unsigned)u) << 16); }
__device__ __forceinline__ float sigmoidf_(float x) { return __builtin_amdgcn_rcpf(1.0f + __expf(-x)); }
__device__ __forceinline__ float siluf_(float x) { return x * __builtin_amdgcn_rcpf(1.0f + __expf(-x)); }
__device__ __forceinline__ float wave_sum(float v) {
#pragma unroll
    for (int o = 1; o < 64; o <<= 1) v += __shfl_xor(v, o);
    return v;
}
__device__ __forceinline__ float wave_max(float v) {
#pragma unroll
    for (int o = 1; o < 64; o <<= 1) v = fmaxf(v, __shfl_xor(v, o));
    return v;
}

namespace pg8 {
constexpr int BM = 256, BK = 64, HALF = 128, HTB = HALF * BK * 2, STAGE_BYTES = 8 * HTB, NXCD = 8, WGM = 8;
__host__ __device__ __forceinline__ int lds_byte(int r, int c) { const int st = (r >> 4) * 2 + (c >> 5), rr = r & 15, cc = c & 31, ob = rr * 64 + cc * 2; return st * 1024 + (ob ^ (((ob >> 9) & 1) << 5)); }
__host__ __device__ __forceinline__ void stage_rc(int b, int& R, int& C) { const int st = b / 1024, sb = b % 1024, swz = sb ^ (((sb >> 9) & 1) << 5); R = (st >> 1) * 16 + swz / 64; C = (st & 1) * 32 + (swz % 64) / 2; }
__host__ __device__ __forceinline__ int perm32(int rho) { const int n = rho >> 4, i = rho & 15; return 8 * (i >> 2) + 4 * n + (i & 3); }

struct Unit { int pm, pn, which; };

struct Sched {
    int nM, nN, nwg, G, c, NW, wgm = WGM; bool rev = false;
    const char* A[2]; const char* B[2]; size_t tstep;
    __device__ void init(int M, int N, int K, int G_, int c_, int NW_, const void* A0, const void* B0, const void* A1, const void* B1) {
        nM = M / BM; nN = N / BM; nwg = nM * nN; G = G_; c = c_; NW = NW_; A[0] = (const char*)A0; A[1] = (const char*)A1; B[0] = (const char*)B0; B[1] = (const char*)B1; tstep = (size_t)BM * K * 2; }
    __device__ bool next(int i, Unit& u) const {
        const int it = (NW == 2) ? (i >> 1) : i;
        const long L = (long)it * G + c; if (L >= nwg) return false;
        int wgid = (int)L; { const int q = nwg / NXCD, r = nwg % NXCD, xcd = wgid % NXCD, off = wgid / NXCD; wgid = (xcd < r ? xcd * (q + 1) : r * (q + 1) + (xcd - r) * q) + off; }
        const int nig = wgm * nN, gid = wgid / nig, fm = gid * wgm, gsz = (nM - fm) < wgm ? (nM - fm) : wgm;
        u.pm = fm + ((wgid % nig) % gsz); u.pn = (wgid % nig) / gsz; if (rev) u.pn = nN - 1 - u.pn; u.which = (NW == 2) ? (i & 1) : 0; return true;
    }
    __device__ __forceinline__ const char* abase(const Unit& u) const { return (u.which ? A[1] : A[0]) + (size_t)u.pm * tstep; }
    __device__ __forceinline__ const char* bbase(const Unit& u) const { return (u.which ? B[1] : B[0]) + (size_t)u.pn * tstep; }
};

template <class Epi, bool ALIGN_EPI = true>
__device__ __forceinline__ void gemm_phase(LAS unsigned char* lds, const int K, const Sched& S, const Epi& E, const int tid) {
    const int wid = __builtin_amdgcn_readfirstlane(tid >> 6), lane = tid & 63, wr = wid >> 2, wc = wid & 3, fr = lane & 15, fq = lane >> 4;
    const int nt = K / BK;
    unsigned voffA[2], voffB[2];
#pragma unroll
    for (int i = 0; i < 2; ++i) { int R, C; stage_rc(tid * 16 + i * 8192, R, C); const int Rb = Epi::PERM ? ((R & ~31) + perm32(R & 31)) : R;
        voffA[i] = (unsigned)(R * K + C) * 2u; voffB[i] = (unsigned)(Rb * K + C) * 2u; }
    const size_t kstep = (size_t)(BK * 2);
    const size_t hstep = (size_t)HALF * K * 2;
    const unsigned ldsw = (unsigned)wid * 1024u;
    const int aoff = lds_byte(wr * 64 + fr, fq * 8), boff = lds_byte(wc * 32 + fr, fq * 8);
#define PG8_SA(b, h) (((b) * 2 + (h)) * HTB)
#define PG8_SB(b, h) ((4 + (b) * 2 + (h)) * HTB)
#define PG8_STAGE(bufoff, gbase, voff) do { _Pragma("unroll") for (int _i = 0; _i < 2; ++_i) \
        __builtin_amdgcn_global_load_lds((const unsigned*)((const char*)(gbase) + (voff)[_i]), (LAS unsigned*)(lds + (bufoff) + ldsw + _i * 8192), 16, 0, 0); } while (0)
#define PG8_STAGEB(bufoff, gbase, voff) do { _Pragma("unroll") for (int _i = 0; _i < 2; ++_i) \
        __builtin_amdgcn_global_load_lds((const unsigned*)((const char*)(gbase) + (voff)[_i]), (LAS unsigned*)(lds + (bufoff) + ldsw + _i * 8192), 16, 0, Epi::B_NT ? 2 : 0); } while (0)
#define PG8_LDA(dst, b, h) do { _Pragma("unroll") for (int m = 0; m < 4; ++m) _Pragma("unroll") for (int k = 0; k < 2; ++k) dst[m][k] = *(const LAS bf16x8*)(lds + PG8_SA(b, h) + aoff + m * 2048 + k * 1024); } while (0)
#define PG8_LDB(dst, b, h) do { _Pragma("unroll") for (int n = 0; n < 2; ++n) _Pragma("unroll") for (int k = 0; k < 2; ++k) dst[n][k] = *(const LAS bf16x8*)(lds + PG8_SB(b, h) + boff + n * 2048 + k * 1024); } while (0)
#define PG8_MMA(ai, bj, At, Bt) do { __builtin_amdgcn_s_setprio(1); _Pragma("unroll") for (int m = 0; m < 4; ++m) _Pragma("unroll") for (int n = 0; n < 2; ++n) _Pragma("unroll") for (int k = 0; k < 2; ++k) \
        acc[ai][bj][m][n] = __builtin_amdgcn_mfma_f32_16x16x32_bf16(Bt[n][k], At[m][k], acc[ai][bj][m][n], 0, 0, 0); __builtin_amdgcn_s_setprio(0); } while (0)
#define PG8_WAIT_V(n) asm volatile("s_waitcnt vmcnt(" #n ")" ::: "memory")
#define PG8_WAIT_L(n) asm volatile("s_waitcnt lgkmcnt(" #n ")" ::: "memory")
#define PG8_BAR __builtin_amdgcn_s_barrier()
#define PG8_SCHED __builtin_amdgcn_sched_barrier(0)
    Unit cur, nxt; int ui = 0;
    if (!S.next(0, cur)) return;
    f32x4 acc[2][2][4][2];
#pragma unroll
    for (int a = 0; a < 2; ++a)
#pragma unroll
        for (int b = 0; b < 2; ++b)
#pragma unroll
            for (int m = 0; m < 4; ++m)
#pragma unroll
                for (int n = 0; n < 2; ++n) acc[a][b][m][n] = (f32x4){0.f, 0.f, 0.f, 0.f};
    bf16x8 At[4][2], B0[2][2], B1[2][2];
    const char* cA = S.abase(cur); const char* cB = S.bbase(cur);
    PG8_STAGEB(PG8_SB(0, 0), cB, voffB); PG8_STAGEB(PG8_SB(0, 1), cB + hstep, voffB);
    if constexpr (Epi::WAIT_A) E.pre_a(cur, tid);
    PG8_STAGE(PG8_SA(0, 0), cA, voffA); PG8_STAGE(PG8_SA(0, 1), cA + hstep, voffA);
    if (wr == 1) PG8_BAR;
    PG8_WAIT_V(2); PG8_BAR;
    PG8_STAGEB(PG8_SB(1, 0), cB + kstep, voffB); PG8_STAGE(PG8_SA(1, 0), cA + kstep, voffA); PG8_STAGEB(PG8_SB(1, 1), cB + hstep + kstep, voffB);
    PG8_WAIT_V(6); PG8_BAR;
    for (;;) {
        const bool has_next = S.next(ui + 1, nxt);
        const char* nA = has_next ? S.abase(nxt) : cA; const char* nB = has_next ? S.bbase(nxt) : cB;
        for (int t = 0; t < nt; t += 2) {
            if constexpr (Epi::WAIT_MID) { if (t == nt - 4 && cur.which == 0) E.mid_wait(tid); }
            const bool last = (t == nt - 2);
            const char* a1 = cA + (size_t)(t + 1) * kstep;
            const char* a2 = last ? nA : cA + (size_t)(t + 2) * kstep; const char* b2 = last ? nB : cB + (size_t)(t + 2) * kstep;
            const char* a3 = a2 + kstep; const char* b3 = b2 + kstep;
            PG8_LDB(B0, 0, 0); PG8_LDB(B1, 0, 1); PG8_SCHED; PG8_LDA(At, 0, 0); PG8_STAGE(PG8_SA(1, 1), a1 + hstep, voffA);
            PG8_WAIT_V(8); PG8_WAIT_L(0); PG8_BAR; PG8_MMA(0, 0, At, B0); PG8_MMA(0, 1, At, B1); PG8_BAR; PG8_SCHED;
            PG8_LDA(At, 0, 1); PG8_STAGEB(PG8_SB(0, 0), b2, voffB); PG8_STAGEB(PG8_SB(0, 1), b2 + hstep, voffB); PG8_STAGE(PG8_SA(0, 0), a2, voffA);
            PG8_WAIT_V(8); PG8_WAIT_L(0); PG8_BAR; PG8_MMA(1, 0, At, B0); PG8_MMA(1, 1, At, B1); PG8_BAR; PG8_SCHED;
            PG8_LDB(B0, 1, 0); PG8_LDB(B1, 1, 1); PG8_SCHED; PG8_LDA(At, 1, 0); PG8_STAGE(PG8_SA(0, 1), a2 + hstep, voffA);
            PG8_WAIT_V(8); PG8_WAIT_L(0); PG8_BAR; PG8_MMA(0, 0, At, B0); PG8_MMA(0, 1, At, B1); PG8_BAR; PG8_SCHED;
            PG8_LDA(At, 1, 1); PG8_STAGEB(PG8_SB(1, 0), b3, voffB); PG8_STAGEB(PG8_SB(1, 1), b3 + hstep, voffB); PG8_STAGE(PG8_SA(1, 0), a3, voffA);
            PG8_WAIT_V(8); PG8_WAIT_L(0); PG8_BAR; PG8_MMA(1, 0, At, B0); PG8_MMA(1, 1, At, B1); PG8_BAR; PG8_SCHED;
        }
        if constexpr (ALIGN_EPI) { if (wr == 0) PG8_BAR; }
        if constexpr (!Epi::AFTER_DRAIN) E(acc, cur, wr, wc, fr, fq, ui);
        if (!has_next) break;
        if (!Epi::keep_acc(cur)) {
#pragma unroll
        for (int a = 0; a < 2; ++a)
#pragma unroll
            for (int b = 0; b < 2; ++b)
#pragma unroll
                for (int m = 0; m < 4; ++m)
#pragma unroll
                    for (int n = 0; n < 2; ++n) acc[a][b][m][n] = (f32x4){0.f, 0.f, 0.f, 0.f};
        }
        cur = nxt; cA = nA; cB = nB; ++ui;
        if constexpr (ALIGN_EPI) { if (wr == 1) PG8_BAR; }
    }
    PG8_WAIT_V(0);
    if constexpr (!ALIGN_EPI) { if (wr == 0) PG8_BAR; }
    PG8_BAR;
    if constexpr (Epi::AFTER_DRAIN) E.fused(acc, cur, wr, wc, fr, fq, lds, tid);
#undef PG8_SA
#undef PG8_SB
#undef PG8_STAGE
#undef PG8_STAGEB
#undef PG8_LDA
#undef PG8_LDB
#undef PG8_MMA
#undef PG8_WAIT_V
#undef PG8_WAIT_L
#undef PG8_BAR
#undef PG8_SCHED
}
}

#define XB_TMO      128
#define XB_XCNT(j)  (256  + 64 * (j))
#define XB_XSUB(j)  (1280 + 64 * (j))
#define XB_XGEN(j)  (2304 + 64 * (j))
#define XB_TOP      3328
#define XB_TOPGEN   3392
#define XCD_BAR_WORDS 3456
#define XB_SPIN_CAP (1u << 20)
__device__ __forceinline__ unsigned xb_ld(unsigned* p)              { return __hip_atomic_load(p, __ATOMIC_RELAXED, __HIP_MEMORY_SCOPE_AGENT); }
__device__ __forceinline__ unsigned xb_add(unsigned* p, unsigned v) { return __hip_atomic_fetch_add(p, v, __ATOMIC_RELAXED, __HIP_MEMORY_SCOPE_AGENT); }
__device__ __forceinline__ unsigned xb_xcc_id() { return (unsigned)__builtin_amdgcn_s_getreg((3 << 11) | 20) & 0xFu; }
#define XB_SPIN(cond, bar) do { unsigned _sp = 0; while (cond) { __builtin_amdgcn_s_sleep(1); \
    if ((++_sp & 255u) == 0u) { if (xb_ld(&(bar)[XB_TMO])) break; if (_sp > XB_SPIN_CAP) { atomicAdd(&(bar)[XB_TMO], 1u); break; } } } } while (0)
struct XcdBarrier { unsigned* bar; unsigned x; volatile LAS unsigned* st; };
__device__ __forceinline__ XcdBarrier xcd_barrier_post(unsigned* bar, volatile LAS unsigned* st) {
    XcdBarrier b; b.bar = bar; b.x = xb_xcc_id(); b.st = st;
    if (threadIdx.x == 0) (void)xb_add(&bar[XB_XCNT(b.x)], 1u);
    return b;
}
__device__ __forceinline__ void xcd_barrier_complete(unsigned* bar, unsigned x, unsigned& nloc, unsigned& nx) {
    const unsigned G = gridDim.x * gridDim.y * gridDim.z;
    unsigned sum, cnt, mine, sp = 0u;
    for (;;) {
        sum = 0u; cnt = 0u; mine = 0u;
#pragma unroll
        for (unsigned j = 0; j < 16; ++j) { const unsigned c = xb_ld(&bar[XB_XCNT(j)]); sum += c; cnt += (c > 0u) ? 1u : 0u; mine = (j == x) ? c : mine; }
        if (sum == G) break;
        __builtin_amdgcn_s_sleep(1);
        if ((++sp & 255u) == 0u) { if (xb_ld(&bar[XB_TMO])) break; if (sp > XB_SPIN_CAP) { atomicAdd(&bar[XB_TMO], 1u); break; } }
    }
    nloc = mine > 0u ? mine : 1u; nx = cnt > 0u ? cnt : 1u;
}
__device__ __forceinline__ void xcd_barrier(const XcdBarrier& b) {
    asm volatile("s_waitcnt vmcnt(0)" ::: "memory");
    __syncthreads();
    if (threadIdx.x == 0) {
        unsigned* bar = b.bar;
        __builtin_amdgcn_s_waitcnt(0);
        unsigned nloc = b.st[0], nx = b.st[1];
        if (nloc == 0u) { xcd_barrier_complete(bar, b.x, nloc, nx); b.st[0] = nloc; b.st[1] = nx; }
        const unsigned old = xb_add(&bar[XB_XSUB(b.x)], 1u);
        const unsigned gen = old / nloc;
        if (old + 1u == (gen + 1u) * nloc) {
            __builtin_amdgcn_fence(__ATOMIC_RELEASE, "agent");
            asm volatile("s_waitcnt vmcnt(0)" ::: "memory");
            const unsigned og = xb_add(&bar[XB_TOP], 1u);
            const unsigned tg = og / nx;
            if (og + 1u == (tg + 1u) * nx) xb_add(&bar[XB_TOPGEN], 1u);
            else XB_SPIN(xb_ld(&bar[XB_TOPGEN]) == tg, bar);
            __builtin_amdgcn_fence(__ATOMIC_ACQUIRE, "agent");
            xb_add(&bar[XB_XGEN(b.x)], 1u);
            asm volatile("s_waitcnt vmcnt(0)" ::: "memory");
        } else {
            XB_SPIN(xb_ld(&bar[XB_XGEN(b.x)]) == gen, bar);
            __builtin_amdgcn_fence(__ATOMIC_ACQUIRE, "agent");
            asm volatile("s_waitcnt vmcnt(0)" ::: "memory");
        }
    }
    __syncthreads();
}

__device__ __forceinline__ void xl_arrive(unsigned* ctr) {
    asm volatile("s_waitcnt vmcnt(0)" ::: "memory");
    __syncthreads();
    if (threadIdx.x == 0) xb_add(ctr, 1u);
}
__device__ __forceinline__ void xl_wait(unsigned* ctr, unsigned target) {
    if (threadIdx.x == 0) {
        unsigned sp = 0; while (xb_ld(ctr) < target) { __builtin_amdgcn_s_sleep(1); if (++sp > (1u << 22)) break; }
        __builtin_amdgcn_fence(__ATOMIC_ACQUIRE, "agent");
        asm volatile("s_waitcnt vmcnt(0)" ::: "memory");
    }
    __syncthreads();
}
__device__ __forceinline__ void xl_barrier(unsigned* ctr, unsigned target) {
    asm volatile("s_waitcnt vmcnt(0)" ::: "memory");
    __syncthreads();
    if (threadIdx.x == 0) {
        xb_add(ctr, 1u);
        unsigned sp = 0; while (xb_ld(ctr) < target) { __builtin_amdgcn_s_sleep(1); if (++sp > (1u << 22)) break; }
        __builtin_amdgcn_fence(__ATOMIC_ACQUIRE, "agent");
        asm volatile("s_waitcnt vmcnt(0)" ::: "memory");
    }
    __syncthreads();
}

struct Args { const float* in[18]; float* out; unsigned char* ws; int ph_lo, ph_hi, li, pad; };

struct Ctx {
    LAS unsigned char* lds;
    int tid, lane, wave, G, vcu, xcc, rank, vb;
    const float* const* in;
    float* out; unsigned char* ws;
};

constexpr int NPIECES = 43008;
constexpr int NBSLOT = 7, NBPW = 2, NBND = NBSLOT * NBPW * 256 * 8;
struct Piece { const f32x4* s4; f32x4* d4; size_t n4, base; int W; };
__device__ __forceinline__ Piece piece_of(const float* const* in, float* out, int p, int lane) {
    const size_t v = (size_t)p * 1024; int t; size_t off;
    if (v < 1048576u) { t = 0; off = 0; } else if (v < 2097152u) { t = 1; off = 1048576u; } else if (v < 6291456u) { t = 2; off = 2097152u; } else if (v < 10485760u) { t = 3; off = 6291456u; }
    else if (v < 27262976u) { t = 4; off = 10485760u; } else { t = 5; off = 27262976u; }
    Piece P; P.W = 128 << (2 * (t >> 1)); P.n4 = (size_t)DEPTH * DEC_BATCH * P.W * 64;
    const size_t doff = t == 0 ? O_SK0 : t == 1 ? O_SV0 : t == 2 ? O_SK1 : t == 3 ? O_SV1 : t == 4 ? O_SK2 : O_SV2;
    P.s4 = (const f32x4*)in[2 + t]; P.d4 = (f32x4*)(out + doff); P.base = v - off + lane; return P;
}
#define PC_LOAD(R, P, U0, U1) _Pragma("unroll") for (int u_ = (U0); u_ < (U1); ++u_) { const size_t i_ = (P).base + 64 * u_; R[u_] = __builtin_nontemporal_load(&(P).s4[i_ + 64 < (P).n4 ? i_ + 64 : i_]); } __builtin_amdgcn_sched_barrier(0);
#define PC_STORE(R, P, U0, U1) _Pragma("unroll") for (int u_ = (U0); u_ < (U1); ++u_) { const size_t i_ = (P).base + 64 * u_; const int within_ = (int)((i_ >> 6) & (size_t)((P).W - 1)); if (within_ < (P).W - 1) __builtin_nontemporal_store(R[u_], &(P).d4[i_]); }

struct Epi1 {
    static constexpr bool PERM = true, AFTER_DRAIN = false, B_NT = false, WAIT_A = false, WAIT_MID = false;
    static __device__ __forceinline__ bool keep_acc(const pg8::Unit&) { return false; }
    bf16_t* Z; const float* rope; float* out; int layer; const float* const* in; int cslot, cwg;
    __device__ __forceinline__ void operator()(f32x4 (&acc)[2][2][4][2], const pg8::Unit& u, int wr, int wc, int fr, int fq, int ui) const {
        const int ck = (ui & 3) ? 2 : (ui >> 2);
        const int pid = (ck < 2) ? NBND + ((cslot + ck) * NG1 + cwg) * 8 + (wr * 4 + wc) : NPIECES;
        const bool havep = pid < NPIECES;
        Piece CP = piece_of(in, out, havep ? pid : 0, fq * 16 + fr); f32x4 cpr[16];
        if (havep) { PC_LOAD(cpr, CP, 0, 8) }
        __builtin_amdgcn_sched_barrier(0);
        const int pn = u.pn;
        const int row0 = u.pm * 256 + wr * 64 + fr;
        const int colw = wc * 32 + 8 * fq;
        const bool is_rope = (pn < 6) && ((wc & 1) == 0);
        const float qs = (pn < 3) ? QSCALE : 1.0f;
        const bool is_kv = (pn >= 3) && (pn < 9);
        const bool is_glu = (pn >= 12) && (pn < 18);
        const int g = is_kv ? (pn - 3) % 3 : 0; const bool isv = pn >= 6;
        const int Wg = 128 << (2 * g);
        size_t pbase, sbase;
        { const size_t pk[3] = {O_PK0, O_PK1, O_PK2}, pv[3] = {O_PV0, O_PV1, O_PV2}, sk[3] = {O_SK0, O_SK1, O_SK2}, sv[3] = {O_SV0, O_SV1, O_SV2};
          pbase = isv ? pv[g] : pk[g]; sbase = isv ? sv[g] : sk[g]; }
        const float sgn = (fq == 0) ? -1.0f : 1.0f;
#pragma unroll
        for (int ai = 0; ai < 2; ++ai)
#pragma unroll
            for (int m = 0; m < 4; ++m) {
                if (ai == 1 && m == 0) { __builtin_amdgcn_sched_barrier(0); if (havep) { PC_LOAD(cpr, CP, 8, 16) } }
                const int r = row0 + ai * 128 + m * 16;
                f32x4 cs0, cs1, sn0, sn1;
                if (is_rope) {
                    const int pidx = (r < MP) ? (r & 2047) : 2048;
                    const f32x4* rp = (const f32x4*)(rope + (size_t)pidx * 16);
                    cs0 = rp[0]; cs1 = rp[1]; sn0 = rp[2]; sn1 = rp[3];
                }
                float* st_dst = nullptr;
                if (is_kv) {
                    if (r < MP) { const int b = r >> 11, s = r & 2047; if (s >= 2048 - Wg) st_dst = out + pbase + ((size_t)((layer * 8 + b) * Wg + (s - (2048 - Wg)))) * 256 + colw; }
                    else if (r < MR) { const int b = r - MP; st_dst = out + sbase + ((size_t)((layer * 32 + b) * Wg + (Wg - 1))) * 256 + colw; }
                }
                bf16_t* zrow = Z + (size_t)r * ZN + pn * 256 + colw;
                if (is_glu) {
                    const f32x4 a0 = acc[ai][0][m][0], a1 = acc[ai][0][m][1], b0 = acc[ai][1][m][0], b1 = acc[ai][1][m][1];
                    f32x4 u0, u1;
#pragma unroll
                    for (int e = 0; e < 4; ++e) { u0[e] = a0[e] * sigmoidf_(b0[e]); u1[e] = a1[e] * sigmoidf_(b1[e]); }
                    u32x4 w; w.x = cvt_pk_bf16(u0[0], u0[1]); w.y = cvt_pk_bf16(u0[2], u0[3]); w.z = cvt_pk_bf16(u1[0], u1[1]); w.w = cvt_pk_bf16(u1[2], u1[3]);
                    *(u32x4*)zrow = w;
                    const int s = r & 2047;
                    if (s >= 2018) { float* pc = out + O_PC + ((size_t)((layer * 8 + (r >> 11)) * 30 + (s - 2018))) * 768 + (pn - 12) * 128 + colw; __builtin_nontemporal_store(u0, (f32x4*)pc); __builtin_nontemporal_store(u1, (f32x4*)(pc + 4)); }
                    continue;
                }
#pragma unroll
                for (int bj = 0; bj < 2; ++bj) {
                    f32x4 v0 = acc[ai][bj][m][0], v1 = acc[ai][bj][m][1];
                    if (is_rope) {
                        f32x4 p0, p1;
#pragma unroll
                        for (int e = 0; e < 4; ++e) { p0[e] = __shfl_xor(v0[e], 16); p1[e] = __shfl_xor(v1[e], 16); }
                        if (fq < 2) { v0 = v0 * cs0 + (p0 * sn0) * sgn; v1 = v1 * cs1 + (p1 * sn1) * sgn; }
                    }
                    v0 = v0 * qs; v1 = v1 * qs;
                    if (st_dst) { __builtin_nontemporal_store(v0, (f32x4*)(st_dst + bj * 128)); __builtin_nontemporal_store(v1, (f32x4*)(st_dst + bj * 128 + 4)); }
                    u32x4 w; w.x = cvt_pk_bf16(v0[0], v0[1]); w.y = cvt_pk_bf16(v0[2], v0[3]); w.z = cvt_pk_bf16(v1[0], v1[1]); w.w = cvt_pk_bf16(v1[2], v1[3]);
                    *(u32x4*)(zrow + bj * 128) = w;
                }
            }
        __builtin_amdgcn_sched_barrier(0);
        if (havep) { PC_STORE(cpr, CP, 0, 16) }
    }
};

struct Epi2 {
    static constexpr bool PERM = true, AFTER_DRAIN = false, B_NT = false, WAIT_A = true, WAIT_MID = true;
    static __device__ __forceinline__ bool keep_acc(const pg8::Unit& u) { return u.which == 0; }
    const bf16_t* Z; bf16_t* MG; unsigned* xc; unsigned* xp; unsigned xtarget;
    __device__ __forceinline__ void wait_ctr(const unsigned* ctr, int tid) const {
        if (tid == 0) { unsigned sp = 0; while (xb_ld((unsigned*)ctr) < xtarget) { __builtin_amdgcn_s_sleep(1); if (++sp > (1u << 22)) break; }
            __builtin_amdgcn_fence(__ATOMIC_ACQUIRE, "agent"); }
        __builtin_amdgcn_s_barrier();
    }
    __device__ __forceinline__ void pre_a(const pg8::Unit&, int tid) const { wait_ctr(xc, tid); }
    __device__ __forceinline__ void mid_wait(int tid) const { wait_ctr(xp, tid); }
    __device__ __forceinline__ void operator()(f32x4 (&acc)[2][2][4][2], const pg8::Unit& u, int wr, int wc, int fr, int fq, int ui) const {
        const int row0 = u.pm * 256 + wr * 64 + fr, col0 = u.pn * 256 + wc * 32 + 8 * fq;
#pragma unroll
        for (int ai = 0; ai < 2; ++ai) {
            u32x4 gc_[4][2], ga_[4][2];
#pragma unroll
            for (int m = 0; m < 4; ++m)
#pragma unroll
                for (int bj = 0; bj < 2; ++bj) { const int r = row0 + ai * 128 + m * 16;
                    gc_[m][bj] = (u.which == 0) ? *(const u32x4*)(Z + (size_t)r * ZN + ZC_MA + col0 + bj * 128) : __builtin_nontemporal_load((const u32x4*)(Z + (size_t)r * ZN + ZC_MA + col0 + bj * 128));
                    ga_[m][bj] = (u.which == 0) ? __builtin_nontemporal_load((const u32x4*)(Z + (size_t)r * ZN + ZC_MC + col0 + bj * 128)) : (u32x4){0u, 0u, 0u, 0u}; }
            __builtin_amdgcn_sched_barrier(0);
#pragma unroll
            for (int m = 0; m < 4; ++m)
#pragma unroll
                for (int bj = 0; bj < 2; ++bj) { const int r = row0 + ai * 128 + m * 16;
                    const u32x4 c = gc_[m][bj], a = ga_[m][bj];
                    f32x4 v0 = acc[ai][bj][m][0], v1 = acc[ai][bj][m][1];
                    if (u.which == 0) {
                        v0[0] *= sigmoidf_(bf_lo(a.x)) * (1.0f + __expf(-bf_lo(c.x))); v0[1] *= sigmoidf_(bf_hi(a.x)) * (1.0f + __expf(-bf_hi(c.x))); v0[2] *= sigmoidf_(bf_lo(a.y)) * (1.0f + __expf(-bf_lo(c.y))); v0[3] *= sigmoidf_(bf_hi(a.y)) * (1.0f + __expf(-bf_hi(c.y)));
                        v1[0] *= sigmoidf_(bf_lo(a.z)) * (1.0f + __expf(-bf_lo(c.z))); v1[1] *= sigmoidf_(bf_hi(a.z)) * (1.0f + __expf(-bf_hi(c.z))); v1[2] *= sigmoidf_(bf_lo(a.w)) * (1.0f + __expf(-bf_lo(c.w))); v1[3] *= sigmoidf_(bf_hi(a.w)) * (1.0f + __expf(-bf_hi(c.w)));
                        acc[ai][bj][m][0] = v0; acc[ai][bj][m][1] = v1;
                    } else {
                        v0[0] *= sigmoidf_(bf_lo(c.x)); v0[1] *= sigmoidf_(bf_hi(c.x)); v0[2] *= sigmoidf_(bf_lo(c.y)); v0[3] *= sigmoidf_(bf_hi(c.y));
                        v1[0] *= sigmoidf_(bf_lo(c.z)); v1[1] *= sigmoidf_(bf_hi(c.z)); v1[2] *= sigmoidf_(bf_lo(c.w)); v1[3] *= sigmoidf_(bf_hi(c.w));
                        u32x4 w; w.x = cvt_pk_bf16(v0[0], v0[1]); w.y = cvt_pk_bf16(v0[2], v0[3]); w.z = cvt_pk_bf16(v1[0], v1[1]); w.w = cvt_pk_bf16(v1[2], v1[3]);
                        *(u32x4*)(MG + (size_t)r * 1024 + col0 + bj * 128) = w;
                    } }
            __builtin_amdgcn_sched_barrier(0);
        }
    }
};

template <bool FIRST>
struct Epi3F {
    static constexpr bool PERM = true, AFTER_DRAIN = true, B_NT = false, WAIT_A = true, WAIT_MID = false;
    static __device__ __forceinline__ bool keep_acc(const pg8::Unit&) { return false; }
    __device__ __forceinline__ void pre_a(const pg8::Unit& u, int tid) const {
        if (tid == 0) { unsigned sp = 0; while (xb_ld(cnt1 + 64 * u.pm) < target) { __builtin_amdgcn_s_sleep(1); if (++sp > (1u << 22)) break; }
            __builtin_amdgcn_fence(__ATOMIC_ACQUIRE, "agent"); }
        __builtin_amdgcn_s_barrier();
    }
    const float* xsrc; float* y; bf16_t* H; const float* gpost; const float* gpre; float* xb1; float* xb2; unsigned* cnt1; unsigned* cnt2; unsigned target; int last; const float* gprev; float* RS;
    static constexpr bool first = FIRST;
    __device__ __forceinline__ void row_rs(const f32x4 (&v)[2][2][4][2], const pg8::Unit& u, int wr, int wc, int fr, int fq, LAS unsigned char* lds, int tid, float* xb, unsigned* cnt) const {
        LAS float* P = (LAS float*)lds; LAS float* S = P + 1024;
#pragma unroll
        for (int ai = 0; ai < 2; ++ai)
#pragma unroll
            for (int m = 0; m < 4; ++m) { float s = 0.f;
#pragma unroll
                for (int bj = 0; bj < 2; ++bj)
#pragma unroll
                    for (int n = 0; n < 2; ++n) { const f32x4 t = v[ai][bj][m][n]; s += (t[0] * t[0] + t[1] * t[1]) + (t[2] * t[2] + t[3] * t[3]); }
                s += __shfl_xor(s, 16); s += __shfl_xor(s, 32);
                if (fq == 0) P[(ai * 128 + wr * 64 + m * 16 + fr) * 4 + wc] = s; }
        __syncthreads();
        if (tid < 256) { const float t = (P[tid * 4] + P[tid * 4 + 1]) + (P[tid * 4 + 2] + P[tid * 4 + 3]);
            unsigned long long* q = (unsigned long long*)xb + ((size_t)u.pm * 256 + tid) * 4;
            __hip_atomic_store(q + u.pn, ((unsigned long long)target << 32) | __float_as_uint(t), RLX_AGENT);
            float tot = 0.f;
#pragma unroll
            for (int j = 0; j < 4; ++j) { unsigned long long w = __hip_atomic_load(q + j, RLX_AGENT); unsigned sp = 0;
                while ((unsigned)(w >> 32) != target) { __builtin_amdgcn_s_sleep(1); w = __hip_atomic_load(q + j, RLX_AGENT); if (++sp > (1u << 22)) break; }
                tot += __uint_as_float((unsigned)w); }
            S[tid] = 1.0f / sqrtf(tot * (1.f / 1024.f) + RMS_EPS); }
        __syncthreads();
    }
    __device__ __forceinline__ void fused(f32x4 (&acc)[2][2][4][2], const pg8::Unit& u, int wr, int wc, int fr, int fq, LAS unsigned char* lds, int tid) const {
        const LAS float* S = (const LAS float*)lds + 1024;
        const int col0 = u.pn * 256 + wc * 32 + 8 * fq;
        u32x4 hv0[4][2]; float rp[2][4]; f32x4 gi[2][2];
#pragma unroll
        for (int m = 0; m < 4; ++m)
#pragma unroll
            for (int bj = 0; bj < 2; ++bj) hv0[m][bj] = *(const u32x4*)(H + (size_t)(u.pm * 256 + wr * 64 + m * 16 + fr) * 1024 + col0 + bj * 128);
#pragma unroll
        for (int ai = 0; ai < 2; ++ai)
#pragma unroll
            for (int m = 0; m < 4; ++m) rp[ai][m] = RS[u.pm * 256 + ai * 128 + wr * 64 + m * 16 + fr];
#pragma unroll
        for (int bj = 0; bj < 2; ++bj)
#pragma unroll
            for (int n = 0; n < 2; ++n) gi[bj][n] = *(const f32x4*)(gprev + col0 + bj * 128 + n * 4);
        __builtin_amdgcn_sched_barrier(0);
        row_rs(acc, u, wr, wc, fr, fq, lds, tid, xb1, cnt1);
#pragma unroll
        for (int ai = 0; ai < 2; ++ai)
#pragma unroll
            for (int m = 0; m < 4; ++m) rp[ai][m] = __builtin_amdgcn_rcpf(rp[ai][m]);
#pragma unroll
        for (int bj = 0; bj < 2; ++bj)
#pragma unroll
            for (int n = 0; n < 2; ++n)
#pragma unroll
                for (int e = 0; e < 4; ++e) gi[bj][n][e] = __builtin_amdgcn_rcpf(gi[bj][n][e]);
        f32x4 gp[2][2];
#pragma unroll
        for (int bj = 0; bj < 2; ++bj)
#pragma unroll
            for (int n = 0; n < 2; ++n) gp[bj][n] = *(const f32x4*)(gpost + col0 + bj * 128 + n * 4);
#pragma unroll
        for (int ai = 0; ai < 2; ++ai) {
            u32x4 hv[4][2];
#pragma unroll
            for (int m = 0; m < 4; ++m)
#pragma unroll
                for (int bj = 0; bj < 2; ++bj) hv[m][bj] = (ai == 0) ? hv0[m][bj] : *(const u32x4*)(H + (size_t)(u.pm * 256 + 128 + wr * 64 + m * 16 + fr) * 1024 + col0 + bj * 128);
            __builtin_amdgcn_sched_barrier(0);
#pragma unroll
            for (int m = 0; m < 4; ++m) { const float rs = S[ai * 128 + wr * 64 + m * 16 + fr];
#pragma unroll
                for (int bj = 0; bj < 2; ++bj) { const u32x4 hh = hv[m][bj];
                    const f32x4 x0 = (f32x4){bf_lo(hh.x), bf_hi(hh.x), bf_lo(hh.y), bf_hi(hh.y)} * gi[bj][0] * rp[ai][m], x1 = (f32x4){bf_lo(hh.z), bf_hi(hh.z), bf_lo(hh.w), bf_hi(hh.w)} * gi[bj][1] * rp[ai][m];
                    acc[ai][bj][m][0] = x0 + (acc[ai][bj][m][0] * rs) * gp[bj][0]; acc[ai][bj][m][1] = x1 + (acc[ai][bj][m][1] * rs) * gp[bj][1]; } }
            __builtin_amdgcn_sched_barrier(0);
        }
        if (!last) {
            __syncthreads();
            row_rs(acc, u, wr, wc, fr, fq, lds, tid, xb2, cnt2);
            if (u.pn == 0 && tid < 256) RS[u.pm * 256 + tid] = S[tid];
#pragma unroll
            for (int bj = 0; bj < 2; ++bj)
#pragma unroll
                for (int n = 0; n < 2; ++n) gp[bj][n] = *(const f32x4*)(gpre + col0 + bj * 128 + n * 4);
        }
#pragma unroll
        for (int ai = 0; ai < 2; ++ai)
#pragma unroll
            for (int m = 0; m < 4; ++m) { const int rl = ai * 128 + wr * 64 + m * 16 + fr; const size_t off = (size_t)(u.pm * 256 + rl) * 1024 + col0; const float rs2 = S[rl];
#pragma unroll
                for (int bj = 0; bj < 2; ++bj) { const f32x4 x0 = acc[ai][bj][m][0], x1 = acc[ai][bj][m][1];
                    if (last) { __builtin_nontemporal_store(x0, (f32x4*)(y + off + bj * 128)); __builtin_nontemporal_store(x1, (f32x4*)(y + off + bj * 128 + 4)); }
                    else { const f32x4 h0 = (x0 * rs2) * gp[bj][0], h1 = (x1 * rs2) * gp[bj][1]; u32x4 w; w.x = cvt_pk_bf16(h0[0], h0[1]); w.y = cvt_pk_bf16(h0[2], h0[3]); w.z = cvt_pk_bf16(h1[0], h1[1]); w.w = cvt_pk_bf16(h1[2], h1[3]);
                        *(u32x4*)(H + off + bj * 128) = w; } } }
    }
};

struct TrItem { const float* W; bf16_t* WT; int K, N, item; bool remap; };
__device__ __forceinline__ void tr_load(const TrItem& T, int lane, float (&wr_)[32]) {
    const int nblk = T.N / 32, kb = T.item / nblk, nb = T.item % nblk, k0 = 64 * kb, n0 = 32 * nb;
#pragma unroll
    for (int i = 0; i < 32; ++i) { const int kk = 2 * i + (lane >> 5); wr_[i] = __builtin_nontemporal_load(&T.W[(size_t)(k0 + kk) * T.N + n0 + (lane & 31)]); }
    __builtin_amdgcn_sched_barrier(0);
}
__device__ __forceinline__ void tr_finish(const TrItem& T, LAS float* scr, int lane, const float (&wr_)[32]) {
    const int nblk = T.N / 32, kb = T.item / nblk, nb = T.item % nblk, k0 = 64 * kb, n0 = 32 * nb;
    int r0 = n0;
    if (T.remap && n0 >= ZC_CA && n0 < ZC_GC) r0 = (n0 < ZC_CB) ? zc_ca(n0 - ZC_CA) : zc_ca(n0 - ZC_CB) + 128;
#pragma unroll
    for (int i = 0; i < 32; ++i) { const int kk = 2 * i + (lane >> 5); scr[kk * 33 + (lane & 31)] = wr_[i]; }
    LDS_WAIT(); asm volatile("" ::: "memory");
    const int c = lane & 7;
#pragma unroll
    for (int j = 0; j < 4; ++j) { const int n = (lane >> 3) + 8 * j; const LAS float* s = scr + (8 * c) * 33 + n;
        u32x4 o; o.x = cvt_pk_bf16(s[0 * 33], s[1 * 33]); o.y = cvt_pk_bf16(s[2 * 33], s[3 * 33]); o.z = cvt_pk_bf16(s[4 * 33], s[5 * 33]); o.w = cvt_pk_bf16(s[6 * 33], s[7 * 33]);
        *(u32x4*)(T.WT + (size_t)(r0 + n) * T.K + k0 + 8 * c) = o; }
    LDS_WAIT(); asm volatile("" ::: "memory");
}
__device__ __forceinline__ TrItem tr_decode(Ctx& X, int it) {
    constexpr int I_IN = (1024 / 64) * (ZN / 32), I_AO = (768 / 64) * (1024 / 32);
    constexpr int PER_L = I_IN + 2 * I_AO + (1024 / 64) * (1024 / 32);
    const int l = it / PER_L; int r = it % PER_L; TrItem T;
    if (r < I_IN) { T.W = X.in[9] + (size_t)l * 1024 * ZN; T.WT = (bf16_t*)(X.ws + WS_WIN + l * SZ_WIN1); T.K = 1024; T.N = ZN; T.item = r; T.remap = true; return T; } r -= I_IN;
    if (r < I_AO) { T.W = X.in[10] + (size_t)l * 768 * 1024; T.WT = (bf16_t*)(X.ws + WS_WAO + l * SZ_WAO1); T.K = 768; T.N = 1024; T.item = r; T.remap = false; return T; } r -= I_AO;
    if (r < I_AO) { T.W = X.in[11] + (size_t)l * 768 * 1024; T.WT = (bf16_t*)(X.ws + WS_WCO + l * SZ_WAO1); T.K = 768; T.N = 1024; T.item = r; T.remap = false; return T; } r -= I_AO;
    T.W = X.in[12] + (size_t)l * 1024 * 1024; T.WT = (bf16_t*)(X.ws + WS_WO + l * SZ_WO1); T.K = 1024; T.N = 1024; T.item = r; T.remap = false; return T;
}
__device__ __forceinline__ void weight_transposes(Ctx& X, int gw0, int ngw) {
    LAS float* scr = (LAS float*)(X.lds + X.wave * 16384);
    constexpr int NITEMS = 4 * ((1024 / 64) * (ZN / 32) + 2 * (768 / 64) * (1024 / 32) + (1024 / 64) * (1024 / 32));
    int it = gw0; if (it >= NITEMS) return;
    float ra[32], rb[32];
    TrItem Tc = tr_decode(X, it); tr_load(Tc, X.lane, ra);
#pragma unroll 1
    for (;;) {
        const int itn = it + ngw; const bool more = itn < NITEMS;
        TrItem Tn = Tc; if (more) { Tn = tr_decode(X, itn); tr_load(Tn, X.lane, rb); }
        tr_finish(Tc, scr, X.lane, ra);
        if (!more) break;
#pragma unroll
        for (int i = 0; i < 32; ++i) ra[i] = rb[i];
        Tc = Tn; it = itn;
    }
}
__device__ __forceinline__ void rms_row_to_bf16(const float* xrow, const float* g, bf16_t* orow, int lane, float* rs_out) {
    const f32x4* xr = (const f32x4*)xrow + lane; const f32x4* gr = (const f32x4*)g + lane;
    f32x4 v[4], gv[4]; float s = 0.f;
#pragma unroll
    for (int j = 0; j < 4; ++j) { v[j] = xr[64 * j]; gv[j] = gr[64 * j]; }
    __builtin_amdgcn_sched_barrier(0);
#pragma unroll
    for (int j = 0; j < 4; ++j) s += (v[j].x * v[j].x + v[j].y * v[j].y) + (v[j].z * v[j].z + v[j].w * v[j].w);
    const float rs = 1.0f / sqrtf(wave_sum(s) * (1.f / 1024.f) + RMS_EPS);
    if (rs_out && lane == 0) *rs_out = rs;
    u32x2* o8 = (u32x2*)orow + lane;
#pragma unroll
    for (int j = 0; j < 4; ++j) { const f32x4 gg = gv[j]; u32x2 w; w.x = cvt_pk_bf16(v[j].x * rs * gg.x, v[j].y * rs * gg.y); w.y = cvt_pk_bf16(v[j].z * rs * gg.z, v[j].w * rs * gg.w); o8[64 * j] = w; }
}
__device__ __forceinline__ void p0_prep(Ctx& X) {
    const int gw = X.vcu * NWAVES + X.wave, NGW = X.G * NWAVES;
    weight_transposes(X, gw, NGW);
    {
        float* rope = (float*)(X.ws + WS_ROPE);
        const int gt = X.vcu * 512 + X.tid, NT = X.G * 512;
        for (int i = gt; i < 2049 * 8; i += NT) {
            const int pidx = i >> 3, e = i & 7; const int pos = (pidx < 2048) ? pidx : 8192;
            const float inv = e == 0 ? 1.0f : e == 1 ? 0.19392274474868576f : e == 2 ? 0.03760603093086393f : e == 3 ? 0.007292664737217109f : e == 4 ? 0.001414213562373095f
                            : e == 5 ? 0.0002742481756762073f : e == 6 ? 5.318295896944988e-05f : 1.031338537721246e-05f;
            const float ang = (float)pos * inv;
            const float k = rintf(ang * 0.15915494309189535f);
            float r = fmaf(-k, 6.2831854820251465f, ang); r = fmaf(-k, -1.7484556025237907e-07f, r);
            const float rev = r * 0.15915494309189535f;
            rope[pidx * 16 + e] = __builtin_amdgcn_cosf(rev); rope[pidx * 16 + 8 + e] = __builtin_amdgcn_sinf(rev);
        }
    }
    {
        float* cwt = (float*)(X.ws + WS_CWT);
        const int gt = X.vcu * 512 + X.tid, NT = X.G * 512;
        for (int i = gt; i < 4 * 768 * 32; i += NT) { const int l = i / (768 * 32), r = i % (768 * 32), c = r >> 5, k = r & 31; cwt[i] = (k < 31) ? X.in[13][((size_t)l * 31 + k) * 768 + c] : 0.f; }
    }
    {
        bf16_t* H = (bf16_t*)(X.ws + WS_H);
        for (int m = gw; m < MPAD; m += NGW) {
            if (m < MR) { const float* xr = (m < MP) ? X.in[0] + (size_t)m * 1024 : X.in[1] + (size_t)(m - MP) * 1024; rms_row_to_bf16(xr, X.in[16], H + (size_t)m * 1024, X.lane, (m < MP) ? (float*)(X.ws + WS_RS) + m : nullptr); }
            else { u32x4* o = (u32x4*)(H + (size_t)m * 1024) + X.lane; o[0] = (u32x4){0u, 0u, 0u, 0u}; o[64] = (u32x4){0u, 0u, 0u, 0u}; }
        }
    }
}

__device__ __forceinline__ int crow(int r, int hi) { return (r & 3) + 8 * (r >> 2) + 4 * hi; }
__device__ __forceinline__ s16x4 vtr(LAS const unsigned char* p) { typedef short v4i16_t __attribute__((ext_vector_type(4))); return __builtin_bit_cast(s16x4, __builtin_amdgcn_ds_read_tr16_b64_v4i16((LAS v4i16_t*)p)); }

__device__ __forceinline__ void conv_issue(const bf16_t* Z, int unit, int tid, u32x4 (&ra)[12]);
struct AttnGeo { int h, dsh, c0, tb0, tw0, two; };
__device__ __forceinline__ AttnGeo attn_geo(int u) {
    AttnGeo G; G.h = u >> 3; const int sub = u & 7, g = G.h >> 2; G.dsh = 2 * g;
    if (g == 0) { G.c0 = 0; G.tb0 = 8 * sub; G.tw0 = 256 * sub - 128; G.two = 0; }
    else if (g == 1) { G.c0 = sub >> 1; G.tb0 = 8 * (sub & 1); G.tw0 = 256 * (sub & 1) - 128; G.two = 0; }
    else { G.c0 = 2 * sub; G.tb0 = 0; G.tw0 = 0; G.two = 1; }
    return G;
}
constexpr int AT_OST = 98304, AT_SCR = 131072;
__device__ __forceinline__ void attn_issue(const bf16_t* Z, int b, int u, int tid, u32x4 (&pf)[12]) {
    const AttnGeo G = attn_geo(u);
    const size_t rowb = (size_t)b * 2048; const int isv = tid >> 8, ch = tid & 255, key = ch >> 3, dch = ch & 7;
    const int col = (isv ? ZC_V : ZC_K) + G.h * 64 + dch * 8;
#pragma unroll
    for (int s = 0; s < 12; ++s) {
        int t, c; if (G.two) { t = 32 * (s & 3) + key; c = G.c0 + (s >> 2); } else { t = G.tw0 + 32 * s + key; c = G.c0; }
        const bool ok = G.two ? (s < 8) : (t >= 0);
        const size_t m = rowb + ((size_t)(ok ? t : 0) << G.dsh) + c;
        pf[s] = ok ? __builtin_nontemporal_load((const u32x4*)(Z + m * ZN + col)) : (u32x4){0u, 0u, 0u, 0u};
    }
    __builtin_amdgcn_sched_barrier(0);
}
__device__ __forceinline__ void attn_issue_q(const bf16_t* Z, int b, int u, int wave, int lane, bf16x8 (&qn)[4]) {
    const AttnGeo G = attn_geo(u); const size_t rowb = (size_t)b * 2048;
    const int r32 = lane & 31, hi = lane >> 5;
    const int cw = G.two ? G.c0 + (wave >> 2) : G.c0, tb = G.two ? (wave & 3) : G.tb0 + wave;
    const size_t mq = rowb + ((size_t)(tb * 32 + r32) << G.dsh) + cw;
#pragma unroll
    for (int d0 = 0; d0 < 4; ++d0) qn[d0] = *(const bf16x8*)(Z + mq * ZN + ZC_Q + G.h * 64 + d0 * 16 + hi * 8);
    __builtin_amdgcn_sched_barrier(0);
}
__device__ __forceinline__ void attn_stage_write(LAS unsigned char* lds, int tid, const u32x4 (&pf)[12]) {
    const int isv = tid >> 8, ch = tid & 255, key = ch >> 3, dch = ch & 7;
    const int off = isv ? 4096 + (dch >> 2) * 2048 + (key >> 4) * 1024 + ((key >> 3) & 1) * 512 + (key & 7) * 64 + (dch & 3) * 16 : key * 128 + ((dch ^ (key & 7)) << 4);
#pragma unroll
    for (int s = 0; s < 12; ++s) *(LAS u32x4*)(lds + s * 8192 + off) = pf[s];
}
__device__ __forceinline__ void attn_compute(const bf16_t* Z, bf16_t* A2, float* LSE, int b, int u, int un, LAS unsigned char* lds, int tid, int wave, int lane, u32x4 (&pf)[12], bf16x8 (&qr)[4], int cunit) {
    const AttnGeo G = attn_geo(u);
    const int r32 = lane & 31, hi = lane >> 5; const int h = G.h, dsh = G.dsh;
    const int c = G.two ? G.c0 + (wave >> 2) : G.c0, tb = G.two ? (wave & 3) : G.tb0 + wave;
    const int sl0 = G.two ? 4 * (wave >> 2) + (wave & 3) - 4 : wave;
    const size_t rowb = (size_t)b * 2048; const size_t mq = rowb + ((size_t)(tb * 32 + r32) << dsh) + c;
    const int jlo = tb >= 4 ? 0 : 4 - tb;
    f32x16 S[5]; const float NEG = -INFINITY;
#pragma unroll
    for (int j = 0; j < 5; ++j) {
        if (j >= jlo) {
            const LAS unsigned char* kb = lds + (sl0 + j) * 8192 + r32 * 128;
            bf16x8 kf[4];
#pragma unroll
            for (int d0 = 0; d0 < 4; ++d0) kf[d0] = *(const LAS bf16x8*)(kb + (((2 * d0 + hi) ^ (r32 & 7)) << 4));
            f32x16 a = {};
#pragma unroll
            for (int d0 = 0; d0 < 4; ++d0) a = __builtin_amdgcn_mfma_f32_32x32x16_bf16(kf[d0], qr[d0], a, 0, 0, 0);
            S[j] = a;
        } else {
#pragma unroll
            for (int r = 0; r < 16; ++r) S[j][r] = NEG;
        }
    }
    if (jlo == 0) {
#pragma unroll
        for (int r = 0; r < 16; ++r) if (crow(r, hi) < r32) S[0][r] = NEG;
    }
#pragma unroll
    for (int r = 0; r < 16; ++r) if (crow(r, hi) > r32) S[4][r] = NEG;
    float mx = NEG;
#pragma unroll
    for (int j = 0; j < 5; ++j)
#pragma unroll
        for (int r = 0; r < 16; ++r) mx = fmaxf(mx, S[j][r]);
    mx = fmaxf(mx, __shfl_xor(mx, 32));
    float l = 0.f;
#pragma unroll
    for (int j = 0; j < 5; ++j)
#pragma unroll
        for (int r = 0; r < 16; ++r) { const float p = __builtin_amdgcn_exp2f(S[j][r] - mx); S[j][r] = p; l += p; }
    l += __shfl_xor(l, 32);
    LAS float* scr = (LAS float*)(lds + AT_SCR + wave * 256);
    if (hi == 0) { scr[r32] = __builtin_amdgcn_rcpf(l); LSE[(mq * 4 + (h & 3)) * 4 + (h >> 2)] = (mx + __builtin_amdgcn_logf(l)) * LN2; }
    u32x4 pw[5][2];
#pragma unroll
    for (int j = 0; j < 5; ++j)
#pragma unroll
        for (int s = 0; s < 2; ++s) { pw[j][s].x = cvt_pk_bf16(S[j][8 * s + 0], S[j][8 * s + 1]); pw[j][s].y = cvt_pk_bf16(S[j][8 * s + 2], S[j][8 * s + 3]); pw[j][s].z = cvt_pk_bf16(S[j][8 * s + 4], S[j][8 * s + 5]); pw[j][s].w = cvt_pk_bf16(S[j][8 * s + 6], S[j][8 * s + 7]); }
    __builtin_amdgcn_sched_barrier(0);
    if (un < 96) attn_issue(Z, b, un, tid, pf);
    else conv_issue(Z, cunit, tid, pf);
    f32x16 o0 = {}, o1 = {};
    const int vrd = 4096 + (4 * hi + ((lane & 15) >> 2)) * 64 + ((lane >> 4) & 1) * 32 + (lane & 3) * 8;
#pragma unroll
    for (int j = 0; j < 5; ++j) {
        if (j >= jlo) {
            const LAS unsigned char* vb = lds + (sl0 + j) * 8192 + vrd;
#pragma unroll
            for (int s = 0; s < 2; ++s) {
                const bf16x8 pa = __builtin_bit_cast(bf16x8, pw[j][s]);
                { const s16x4 lo = vtr(vb + s * 1024), hh = vtr(vb + s * 1024 + 512);
                  const bf16x8 vf = (bf16x8){lo[0], lo[1], lo[2], lo[3], hh[0], hh[1], hh[2], hh[3]};
                  o0 = __builtin_amdgcn_mfma_f32_32x32x16_bf16(pa, vf, o0, 0, 0, 0); }
                { const s16x4 lo = vtr(vb + 2048 + s * 1024), hh = vtr(vb + 2048 + s * 1024 + 512);
                  const bf16x8 vf = (bf16x8){lo[0], lo[1], lo[2], lo[3], hh[0], hh[1], hh[2], hh[3]};
                  o1 = __builtin_amdgcn_mfma_f32_32x32x16_bf16(pa, vf, o1, 0, 0, 0); }
            }
        }
    }
    LDS_WAIT();
    LAS bf16_t* stg = (LAS bf16_t*)(lds + AT_OST + wave * 4096);
#pragma unroll
    for (int r = 0; r < 16; ++r) { const int orow = crow(r, hi); const float rl = scr[orow];
        stg[orow * 64 + r32] = (bf16_t)(cvt_pk_bf16(o0[r] * rl, 0.f) & 0xffffu); stg[orow * 64 + 32 + r32] = (bf16_t)(cvt_pk_bf16(o1[r] * rl, 0.f) & 0xffffu); }
    LDS_WAIT();
#pragma unroll
    for (int i = 0; i < 4; ++i) { const int row = i * 8 + (lane >> 3), ch = lane & 7; const u32x4 v = *(const LAS u32x4*)(stg + row * 64 + ch * 8);
        const size_t mo = rowb + ((size_t)(tb * 32 + row) << dsh) + c;
        *(u32x4*)(A2 + mo * AW + h * 64 + ch * 8) = v; }
    LDS_WAIT();
}
__device__ __forceinline__ void attn_prompt_wg(Ctx& X, const bf16_t* Z, bf16_t* A2, float* LSE, int b, u32x4 (&pf)[12], int cunit) {
    attn_issue(Z, b, X.rank, X.tid, pf);
#pragma unroll 1
    for (int u = X.rank; u < 96; u += 32) {
        bf16x8 qr[4];
        attn_issue_q(Z, b, u, X.wave, X.lane, qr);
        attn_stage_write(X.lds, X.tid, pf);
        __syncthreads();
        attn_compute(Z, A2, LSE, b, u, u + 32, X.lds, X.tid, X.wave, X.lane, pf, qr, cunit);
        __syncthreads();
    }
}

__device__ __forceinline__ void attn_sample_unit3(const bf16_t* Z, const float* const* in, bf16_t* A2, int layer, int unit, LAS unsigned char* wl, int lane) {
    const int b = unit >> 2, hs = unit & 3;
    const size_t m = (size_t)MP + b;
    const bf16_t* zr = Z + m * ZN;
    LAS float* sc = (LAS float*)wl;
    const int sub = lane >> 4, e = lane & 15;
    f32x4 og[3]; float lse[3];
#pragma unroll
    for (int g = 0; g < 3; ++g) {
        const int h = g * 4 + hs; const int dsh = 2 * g, d = 1 << dsh, W = 128 << dsh;
        const float* cK = in[2 + 2 * g] + ((size_t)(layer * 32 + b) * W) * 256 + hs * 64;
        const float* cV = in[3 + 2 * g] + ((size_t)(layer * 32 + b) * W) * 256 + hs * 64;
        const unsigned voff = (unsigned)(((3 - sub) * d) * 256 + 4 * e) * 4u;
        const size_t rstep = (size_t)(4 * d) * 256 * 4;
        const char* kb = (const char*)(cK + (size_t)(W - 4 * d) * 256);
        const char* vb = (const char*)(cV + (size_t)(W - 4 * d) * 256);
        f32x4 q4; { const u32x2 qq = *(const u32x2*)(zr + ZC_Q + h * 64 + 4 * e); q4 = (f32x4){bf_lo(qq.x), bf_hi(qq.x), bf_lo(qq.y), bf_hi(qq.y)}; }
        f32x4 kn4; { const u32x2 kk = *(const u32x2*)(zr + ZC_K + h * 64 + 4 * e); kn4 = (f32x4){bf_lo(kk.x), bf_hi(kk.x), bf_lo(kk.y), bf_hi(kk.y)}; }
        f32x4 vn4; { const u32x2 vv = *(const u32x2*)(zr + ZC_V + h * 64 + 4 * e); vn4 = (f32x4){bf_lo(vv.x), bf_hi(vv.x), bf_lo(vv.y), bf_hi(vv.y)}; }
        float pr[32];
        {
            f32x4 k4[32];
#pragma unroll
            for (int it = 0; it < 32; ++it) k4[it] = *(const f32x4*)(kb - (size_t)it * rstep + voff);
            __builtin_amdgcn_sched_barrier(0);
#pragma unroll
            for (int it = 0; it < 32; ++it) pr[it] = (q4.x * k4[it].x + q4.y * k4[it].y) + (q4.z * k4[it].z + q4.w * k4[it].w);
        }
        f32x4 v4[32];
#pragma unroll
        for (int it = 0; it < 32; ++it) v4[it] = *(const f32x4*)(vb - (size_t)it * rstep + voff);
        asm volatile("" ::: "memory"); __builtin_amdgcn_sched_barrier(0);
#pragma unroll
        for (int s = 0; s < 4; ++s) {
            const int half = 16 >> s; const unsigned msk = 0u - (unsigned)((lane >> s) & 1);
#pragma unroll
            for (int i = 0; i < half; ++i) { const unsigned ua = __float_as_uint(pr[i]), ub = __float_as_uint(pr[i + half]);
                const float send = __uint_as_float((ua & msk) | (ub & ~msk)); const float keep = __uint_as_float((ub & msk) | (ua & ~msk)); pr[i] = keep + __shfl_xor(send, 1 << s); }
        }
        { const int it0 = 16 * (e & 1) + 8 * ((e >> 1) & 1) + 4 * ((e >> 2) & 1) + 2 * ((e >> 3) & 1);
          sc[4 * it0 + sub + 1] = pr[0]; sc[4 * (it0 + 1) + sub + 1] = pr[1]; }
        { float p0 = (q4.x * kn4.x + q4.y * kn4.y) + (q4.z * kn4.z + q4.w * kn4.w);
          p0 += __shfl_xor(p0, 1); p0 += __shfl_xor(p0, 2); p0 += __shfl_xor(p0, 4); p0 += __shfl_xor(p0, 8); if (lane == 0) sc[0] = p0; }
        LDS_WAIT();
        const float sa = sc[lane], sb = sc[lane + 64], scc = (lane == 0) ? sc[128] : -INFINITY;
        const float mx = wave_max(fmaxf(fmaxf(sa, sb), scc));
        const float pa = __builtin_amdgcn_exp2f(sa - mx), pb = __builtin_amdgcn_exp2f(sb - mx), pc = __builtin_amdgcn_exp2f(scc - mx);
        const float l = wave_sum(pa + pb + pc);
        LDS_WAIT();
        sc[lane] = pa; sc[lane + 64] = pb; if (lane == 0) sc[128] = pc;
        LDS_WAIT();
        f32x4 acc = {0.f, 0.f, 0.f, 0.f};
#pragma unroll
        for (int it = 0; it < 32; ++it) { const float p = sc[4 * it + sub + 1]; acc = acc + v4[it] * p; }
#pragma unroll
        for (int k = 0; k < 4; ++k) { acc[k] += __shfl_xor(acc[k], 16); acc[k] += __shfl_xor(acc[k], 32); }
        { const float p0 = sc[0]; acc = acc + vn4 * p0; }
        og[g] = acc * (1.0f / l);
        lse[g] = (mx + __builtin_amdgcn_logf(l)) * LN2;
        LDS_WAIT();
        asm volatile("" ::: "memory");
    }
    const float lm = fmaxf(lse[0], fmaxf(lse[1], lse[2]));
    const float e0 = __expf(lse[0] - lm), e1 = __expf(lse[1] - lm), e2 = __expf(lse[2] - lm); const float rs = 1.0f / (e0 + e1 + e2);
    const float al[3] = {e0 * rs, e1 * rs, e2 * rs};
    if (sub == 0) {
#pragma unroll
        for (int g = 0; g < 3; ++g) { const int h = g * 4 + hs; const u32x2 ga = *(const u32x2*)(zr + ZC_GA + h * 64 + 4 * e);
            u32x2 w; w.x = cvt_pk_bf16(og[g].x * al[g] * siluf_(bf_lo(ga.x)), og[g].y * al[g] * siluf_(bf_hi(ga.x))); w.y = cvt_pk_bf16(og[g].z * al[g] * siluf_(bf_lo(ga.y)), og[g].w * al[g] * siluf_(bf_hi(ga.y)));
            st_wt64(A2 + m * AW + h * 64 + 4 * e, w); }
    }
}

__device__ __forceinline__ void bfly32(float (&v)[32], int lane) {
#pragma unroll
    for (int s = 0; s < 5; ++s) {
        const int half = 16 >> s; const unsigned msk = 0u - (unsigned)((lane >> s) & 1);
#pragma unroll
        for (int i = 0; i < half; ++i) { const unsigned ua = __float_as_uint(v[i]), ub = __float_as_uint(v[i + half]);
            const float send = __uint_as_float((ua & msk) | (ub & ~msk)); const float keep = __uint_as_float((ub & msk) | (ua & ~msk)); v[i] = keep + __shfl_xor(send, 1 << s); }
    }
    v[0] += __shfl_xor(v[0], 32);
}
__device__ __forceinline__ int bfly_idx(int lane) { return 16 * (lane & 1) + 8 * ((lane >> 1) & 1) + 4 * ((lane >> 2) & 1) + 2 * ((lane >> 3) & 1) + ((lane >> 4) & 1); }

constexpr int CV_U = 0, CV_STAT = 98304, CV_FIN = CV_STAT + 8 * 32 * 4, CV_W = 100352;
static_assert(CV_W + 8 * 768 * 8 <= LDSCTL_OFF, "conv LDS map");
__device__ __forceinline__ void conv_issue(const bf16_t* Z, int unit, int tid, u32x4 (&ra)[12]) {
    const int b = unit >> 6, s0 = (unit & 63) * 32;
#pragma unroll
    for (int q = 0; q < 12; ++q) { const int ci = tid + 512 * q; const int lr = ci / 96, ch = ci - lr * 96; const int s = s0 - 30 + lr;
        if (ci < 62 * 96 && s >= 0) ra[q] = *(const u32x4*)(Z + ((size_t)b * 2048 + s) * ZN + zc_ca(ch * 8));
        else ra[q] = (u32x4){0u, 0u, 0u, 0u}; }
    __builtin_amdgcn_sched_barrier(0);
}
__device__ __forceinline__ void conv_prompt_wg(Ctx& X, const bf16_t* Z, bf16_t* C2, int layer, int unit0, u32x4 (&ra)[12]) {
    const int tid = X.tid, lane = X.lane;
    const float* cwt = (const float*)(X.ws + WS_CWT) + (size_t)layer * 768 * 32;
    const float* lg = X.in[14] + (size_t)layer * CW; const float* lb = X.in[15] + (size_t)layer * CW;
    LAS bf16_t* U = (LAS bf16_t*)(X.lds + CV_U);
    const int cidx = tid & 255, th = tid >> 8;
    { LAS unsigned char* Wl = X.lds + CV_W;
#pragma unroll
      for (int h = 0; h < 2; ++h) {
        f32x4 wt[6];
#pragma unroll
        for (int k = 0; k < 6; ++k) wt[k] = *(const f32x4*)(cwt + (size_t)(tid + 512 * (6 * h + k)) * 4);
        __builtin_amdgcn_sched_barrier(0);
#pragma unroll
        for (int k = 0; k < 6; ++k) { const int idx = tid + 512 * (6 * h + k), c = idx >> 3, g = idx & 7; u32x2 w; w.x = cvt_pk_bf16(wt[k].x, wt[k].y); w.y = cvt_pk_bf16(wt[k].z, wt[k].w); *(LAS u32x2*)(Wl + (g * 768 + c) * 8) = w; }
        __builtin_amdgcn_sched_barrier(0);
      } }
#pragma unroll
    for (int iter = 0; iter < 2; ++iter) {
        const int unit = unit0 + 32 * iter; const int b = unit >> 6, s0 = (unit & 63) * 32;
        u32x4 gcv[6];
#pragma unroll
        for (int q = 0; q < 6; ++q) { const int ci = tid + 512 * q; const int tl = ci / 96, ch = ci - tl * 96; const size_t m = (size_t)b * 2048 + s0 + tl; gcv[q] = __builtin_nontemporal_load((const u32x4*)(Z + m * ZN + ZC_GC + ch * 8)); }
#pragma unroll
        for (int q = 0; q < 12; ++q) { const int ci = tid + 512 * q; const int lr = ci / 96, ch = ci - lr * 96;
            if (ci < 62 * 96) *(LAS u32x4*)(U + lr * 768 + ch * 8) = ra[q]; }
        __syncthreads();
        float cd[3][16];
#pragma unroll
        for (int k = 0; k < 3; ++k) {
            const int c = cidx + 256 * k;
            u32x2 wq[8];
            { const LAS unsigned char* Wl = X.lds + CV_W + c * 8;
#pragma unroll
              for (int g = 0; g < 8; ++g) wq[g] = *(const LAS u32x2*)(Wl + g * 768 * 8); }
            float uu[46];
#pragma unroll
            for (int j = 0; j < 46; ++j) uu[j] = bf1(U[(th * 16 + j) * 768 + c]);
#pragma unroll
            for (int t = 0; t < 16; ++t) cd[k][t] = 0.f;
#pragma unroll
            for (int i = 0; i < 31; ++i) {
                const unsigned wp = (i & 2) ? wq[i >> 2].y : wq[i >> 2].x; const float w = (i & 1) ? bf_hi(wp) : bf_lo(wp);
#pragma unroll
                for (int t = 0; t < 16; ++t) cd[k][t] += uu[t + i] * w; }
            asm volatile("" ::: "memory"); __builtin_amdgcn_sched_barrier(0);
        }
        float st[32];
#pragma unroll
        for (int t = 0; t < 16; ++t) { st[2 * t] = cd[0][t] + cd[1][t] + cd[2][t]; st[2 * t + 1] = cd[0][t] * cd[0][t] + cd[1][t] * cd[1][t] + cd[2][t] * cd[2][t]; }
        bfly32(st, lane);
        LAS float* part = (LAS float*)(X.lds + CV_STAT);
        LAS float* fin = (LAS float*)(X.lds + CV_FIN);
        if (lane < 32) part[X.wave * 32 + bfly_idx(lane)] = st[0];
        __syncthreads();
        if (iter == 0) conv_issue(Z, unit0 + 32, tid, ra);
        if (tid < 64) {
            const int hf = tid >> 5, idx = tid & 31;
            const float tot = part[(hf * 4 + 0) * 32 + idx] + part[(hf * 4 + 1) * 32 + idx] + part[(hf * 4 + 2) * 32 + idx] + part[(hf * 4 + 3) * 32 + idx];
            const float oth = __shfl_xor(tot, 1);
            const float s1 = (idx & 1) ? oth : tot, s2 = (idx & 1) ? tot : oth;
            float inv768 = 1.f / 768.f; asm volatile("" : "+v"(inv768));
            const float mean = s1 * inv768; const float var = fmaxf(s2 * inv768 - mean * mean, 0.f);
            fin[hf * 32 + idx] = (idx & 1) ? (1.0f / sqrtf(var + LN_EPS)) : mean;
        }
        __syncthreads();
        LAS bf16_t* Y = (LAS bf16_t*)(X.lds + CV_U);
#pragma unroll
        for (int k = 0; k < 3; ++k) {
            const int c = cidx + 256 * k; const float gg = lg[c], bb = lb[c];
#pragma unroll
            for (int t = 0; t < 16; ++t) {
                const float mean = fin[th * 32 + 2 * t], rstd = fin[th * 32 + 2 * t + 1];
                const float y = (cd[k][t] - mean) * rstd * gg + bb;
                Y[(th * 16 + t) * 768 + c] = (bf16_t)(cvt_pk_bf16(siluf_(y), 0.f) & 0xffffu);
            }
        }
        __syncthreads();
#pragma unroll
        for (int q = 0; q < 6; ++q) {
            const int ci = tid + 512 * q;
            const int tl = ci / 96, ch = ci - tl * 96; const size_t m = (size_t)b * 2048 + s0 + tl;
            const u32x4 y = *(const LAS u32x4*)(Y + tl * 768 + ch * 8); const u32x4 gc = gcv[q];
            u32x4 w;
            w.x = cvt_pk_bf16(bf_lo(y.x) * siluf_(bf_lo(gc.x)), bf_hi(y.x) * siluf_(bf_hi(gc.x))); w.y = cvt_pk_bf16(bf_lo(y.y) * siluf_(bf_lo(gc.y)), bf_hi(y.y) * siluf_(bf_hi(gc.y)));
            w.z = cvt_pk_bf16(bf_lo(y.z) * siluf_(bf_lo(gc.z)), bf_hi(y.z) * siluf_(bf_hi(gc.z))); w.w = cvt_pk_bf16(bf_lo(y.w) * siluf_(bf_lo(gc.w)), bf_hi(y.w) * siluf_(bf_hi(gc.w)));
            *(u32x4*)(C2 + m * CW + ch * 8) = w;
        }
        __syncthreads();
    }
}

__device__ __forceinline__ void conv_sample_pair(Ctx& X, const bf16_t* Z, bf16_t* C2, int layer, int b0) {
    const float* cwt = (const float*)(X.ws + WS_CWT) + (size_t)layer * 768 * 32;
    const float* lg = X.in[14] + (size_t)layer * CW; const float* lb = X.in[15] + (size_t)layer * CW;
    const int half = X.tid >> 8, ct = X.tid & 255; const int b = b0 + half * NSVC; const bool act = b < DEC_BATCH; const int bb = act ? b : b0;
    const char* stt = (const char*)(X.in[8] + ((size_t)(layer * 32 + bb) * 30) * 768);
    char* sco = (char*)(X.out + O_SC + ((size_t)(layer * 32 + bb) * 30) * 768);
    const size_t m = (size_t)MP + bb; const bf16_t* zr = Z + m * ZN;
    LAS float* red = (LAS float*)(X.lds + CV_STAT);
    float cd[3]; float s1 = 0.f, s2 = 0.f;
    bf16_t zca[3], zcb[3], zgc[3]; f32x4 w4[3][8]; float sv[3][30], gl[3], bl[3];
#pragma unroll
    for (int k = 0; k < 3; ++k) { const int c = ct + 256 * k; const unsigned vo = (unsigned)c * 4u;
        zca[k] = zr[zc_ca(c)]; zcb[k] = zr[zc_ca(c) + 128]; zgc[k] = zr[ZC_GC + c]; gl[k] = lg[c]; bl[k] = lb[c];
        const f32x4* wp = (const f32x4*)(cwt + (size_t)c * 32);
#pragma unroll
        for (int i = 0; i < 8; ++i) w4[k][i] = wp[i];
#pragma unroll
        for (int i = 0; i < 30; ++i) sv[k][i] = *(const float*)(stt + (size_t)i * 3072 + vo); }
    __builtin_amdgcn_sched_barrier(0);
#pragma unroll
    for (int k = 0; k < 3; ++k) { const int c = ct + 256 * k; const unsigned vo = (unsigned)c * 4u;
        const float un = bf1(zca[k]) * sigmoidf_(bf1(zcb[k]));
        float a = un * w4[k][7].z;
#pragma unroll
        for (int i = 0; i < 30; ++i) { a += sv[k][i] * w4[k][i >> 2][i & 3]; if (act && i >= 1) *(float*)(sco + (size_t)(i - 1) * 3072 + vo) = sv[k][i]; }
        if (act) *(float*)(sco + (size_t)29 * 3072 + vo) = un;
        cd[k] = a; s1 += a; s2 += a * a; }
    s1 = wave_sum(s1); s2 = wave_sum(s2);
    if (X.lane == 0) { red[X.wave * 2] = s1; red[X.wave * 2 + 1] = s2; }
    __syncthreads();
    const int w0 = half * 4;
    const float t1 = red[2 * w0] + red[2 * w0 + 2] + red[2 * w0 + 4] + red[2 * w0 + 6], t2 = red[2 * w0 + 1] + red[2 * w0 + 3] + red[2 * w0 + 5] + red[2 * w0 + 7];
    const float mean = t1 * (1.f / 768.f); const float var = fmaxf(t2 * (1.f / 768.f) - mean * mean, 0.f); const float rstd = 1.0f / sqrtf(var + LN_EPS);
    if (act) {
#pragma unroll
        for (int k = 0; k < 3; ++k) { const int c = ct + 256 * k;
            const float y = (cd[k] - mean) * rstd * gl[k] + bl[k];
            const float o = siluf_(y) * siluf_(bf1(zgc[k]));
            st_wt16(C2 + m * CW + c, (bf16_t)(cvt_pk_bf16(o, 0.f) & 0xffffu)); }
    }
    __syncthreads();
}

__device__ __forceinline__ void p2b_fix(Ctx& X) {
    const bf16_t* Z = (const bf16_t*)(X.ws + WS_Z); bf16_t* A2 = (bf16_t*)(X.ws + WS_A2); const float* LSE = (const float*)(X.ws + WS_LSE);
    const int NT = 32 * 512; const int ibase = X.xcc * (SEQ * 96), iend = ibase + SEQ * 96;
    for (int i0 = ibase + X.rank * 512 + X.tid; i0 < iend; i0 += 6 * NT) {
        u32x4 av[6], gv[6]; float l0[6], l1[6], l2[6];
#pragma unroll
        for (int u = 0; u < 6; ++u) { const int i = i0 + u * NT; const int ii = i < iend ? i : i0; const int m = ii / 96, q = ii - m * 96; const int hs = (q >> 3) & 3;
            av[u] = *(const u32x4*)(A2 + (size_t)m * AW + q * 8); gv[u] = __builtin_nontemporal_load((const u32x4*)(Z + (size_t)m * ZN + ZC_GA + q * 8));
            { const f32x4 L4 = *(const f32x4*)(LSE + ((size_t)m * 4 + hs) * 4); l0[u] = L4.x; l1[u] = L4.y; l2[u] = L4.z; } }
        __builtin_amdgcn_sched_barrier(0);
#pragma unroll
        for (int u = 0; u < 6; ++u) { const int i = i0 + u * NT; if (i < iend) { const int m = i / 96, q = i - m * 96; const int g = q >> 5;
            const float mx = fmaxf(l0[u], fmaxf(l1[u], l2[u]));
            const float e0 = __expf(l0[u] - mx), e1 = __expf(l1[u] - mx), e2 = __expf(l2[u] - mx);
            const float al = (g == 0 ? e0 : (g == 1 ? e1 : e2)) * __builtin_amdgcn_rcpf(e0 + e1 + e2);
            const u32x4 a = av[u], ga = gv[u]; u32x4 w;
            w.x = cvt_pk_bf16(bf_lo(a.x) * al * siluf_(bf_lo(ga.x)), bf_hi(a.x) * al * siluf_(bf_hi(ga.x))); w.y = cvt_pk_bf16(bf_lo(a.y) * al * siluf_(bf_lo(ga.y)), bf_hi(a.y) * al * siluf_(bf_hi(ga.y)));
            w.z = cvt_pk_bf16(bf_lo(a.z) * al * siluf_(bf_lo(ga.z)), bf_hi(a.z) * al * siluf_(bf_hi(ga.z))); w.w = cvt_pk_bf16(bf_lo(a.w) * al * siluf_(bf_lo(ga.w)), bf_hi(a.w) * al * siluf_(bf_hi(ga.w)));
            *(u32x4*)(A2 + (size_t)m * AW + q * 8) = w; } }
    }
}

__device__ __forceinline__ void p2_mix(Ctx& X, int layer) {
    const bf16_t* Z = (const bf16_t*)(X.ws + WS_Z); bf16_t* A2 = (bf16_t*)(X.ws + WS_A2); bf16_t* C2 = (bf16_t*)(X.ws + WS_C2); float* LSE = (float*)(X.ws + WS_LSE);
    constexpr int U_PA = 768, U_PC = 512;
    LAS unsigned char* wl = X.lds + X.wave * 12288;
    u32x4 pf[12]; const int cunit0 = X.xcc * (U_PC / 8) + X.rank;
    attn_prompt_wg(X, Z, A2, LSE, X.xcc, pf, cunit0);
    unsigned* xa = (unsigned*)(X.ws + WS_CTL) + CW_XA + 64 * X.xcc;
    asm volatile("s_waitcnt vmcnt(0)" ::: "memory");
    __syncthreads();
    if (X.tid == 0) xb_add(xa, 1u);
    conv_prompt_wg(X, Z, C2, layer, cunit0, pf);
    asm volatile("s_waitcnt vmcnt(0)" ::: "memory");
    __syncthreads();
    if (X.tid == 0) xb_add((unsigned*)(X.ws + WS_CTL) + CW_XC + 64 * X.xcc, 1u);
    if (X.tid == 0) { unsigned sp = 0; while (xb_ld(xa) < 32u * (unsigned)(layer + 1)) { __builtin_amdgcn_s_sleep(1); if (++sp > (1u << 22)) break; }
        __builtin_amdgcn_fence(__ATOMIC_ACQUIRE, "agent"); asm volatile("s_waitcnt vmcnt(0)" ::: "memory"); }
    __syncthreads();
    p2b_fix(X);
    asm volatile("s_waitcnt vmcnt(0)" ::: "memory");
    __syncthreads();
    if (X.tid == 0) xb_add((unsigned*)(X.ws + WS_CTL) + CW_XP + 64 * X.xcc, 1u);
}

template <bool WT>
__device__ __forceinline__ void p5_row(Ctx& X, int layer, int m) {
    const float* R = (const float*)(X.ws + WS_R); bf16_t* H = (bf16_t*)(X.ws + WS_H);
    const float* gpost = X.in[17] + (size_t)layer * 1024; const float* gpre = X.in[16] + (size_t)(layer + 1 < DEPTH ? layer + 1 : 0) * 1024;
    const float* xrow = (layer == 0) ? ((m < MP) ? X.in[0] + (size_t)m * 1024 : X.in[1] + (size_t)(m - MP) * 1024) : X.out + (size_t)m * 1024;
    float* yrow = X.out + (size_t)m * 1024;
    const f32x4* rr = (const f32x4*)(R + (size_t)m * 1024) + X.lane; const f32x4* xr = (const f32x4*)xrow + X.lane;
    f32x4 rv[4], xv[4], gp[4], gq[4]; float s = 0.f;
#pragma unroll
    for (int j = 0; j < 4; ++j) { rv[j] = rr[64 * j]; xv[j] = xr[64 * j]; gp[j] = ((const f32x4*)gpost)[X.lane + 64 * j]; gq[j] = ((const f32x4*)gpre)[X.lane + 64 * j]; }
    __builtin_amdgcn_sched_barrier(0);
#pragma unroll
    for (int j = 0; j < 4; ++j) s += (rv[j].x * rv[j].x + rv[j].y * rv[j].y) + (rv[j].z * rv[j].z + rv[j].w * rv[j].w);
    const float rs = 1.0f / sqrtf(wave_sum(s) * (1.f / 1024.f) + RMS_EPS);
    float s2 = 0.f;
#pragma unroll
    for (int j = 0; j < 4; ++j) { xv[j] = xv[j] + (rv[j] * rs) * gp[j]; if (WT) st16f_wt((f32x4*)yrow + X.lane + 64 * j, xv[j]); else ((f32x4*)yrow)[X.lane + 64 * j] = xv[j];
        s2 += (xv[j].x * xv[j].x + xv[j].y * xv[j].y) + (xv[j].z * xv[j].z + xv[j].w * xv[j].w); }
    if (layer + 1 < DEPTH) {
        const float rs2 = 1.0f / sqrtf(wave_sum(s2) * (1.f / 1024.f) + RMS_EPS);
        u32x2* o8 = (u32x2*)(H + (size_t)m * 1024) + X.lane;
#pragma unroll
        for (int j = 0; j < 4; ++j) { const f32x4 gg = gq[j]; u32x2 w; w.x = cvt_pk_bf16(xv[j].x * rs2 * gg.x, xv[j].y * rs2 * gg.y); w.y = cvt_pk_bf16(xv[j].z * rs2 * gg.z, xv[j].w * rs2 * gg.w); if (WT) st_wt64(o8 + 64 * j, w); else o8[64 * j] = w; }
    }
}

template <int K>
__device__ __forceinline__ f32x16 skinny_block(const bf16_t* A, int lda, const bf16_t* Bt, int lane) {
    const int r32 = lane & 31, hi = lane >> 5;
    const bf16_t* ap = A + (size_t)r32 * lda + hi * 8; const bf16_t* bp = Bt + (size_t)r32 * K + hi * 8;
    f32x16 acc = {};
    bf16x8 a0[8], b0[8], a1[8], b1[8];
#define SK_LOAD(a, b, k0) _Pragma("unroll") for (int j = 0; j < 8; ++j) { a[j] = *(const bf16x8*)(ap + (k0) + 16 * j); b[j] = *(const bf16x8*)(bp + (k0) + 16 * j); } __builtin_amdgcn_sched_barrier(0)
#define SK_MMA(a, b) _Pragma("unroll") for (int j = 0; j < 8; ++j) acc = __builtin_amdgcn_mfma_f32_32x32x16_bf16(a[j], b[j], acc, 0, 0, 0); __builtin_amdgcn_sched_barrier(0)
    SK_LOAD(a0, b0, 0);
#pragma unroll 1
    for (int k0 = 0; k0 < K; k0 += 256) {
        SK_LOAD(a1, b1, k0 + 128);
        SK_MMA(a0, b0);
        if (k0 + 256 < K) { SK_LOAD(a0, b0, k0 + 256); }
        SK_MMA(a1, b1);
    }
#undef SK_LOAD
#undef SK_MMA
    return acc;
}
__device__ __forceinline__ void svc_barrier(Ctx& X, unsigned target) {
    unsigned* ctr = (unsigned*)(X.ws + WS_CTL) + CW_SVC;
    asm volatile("s_waitcnt vmcnt(0)" ::: "memory");
    __syncthreads();
    if (X.tid == 0) {
        xb_add(ctr, 1u);
        unsigned sp = 0; while (xb_ld(ctr) < target) { __builtin_amdgcn_s_sleep(1); if (++sp > (1u << 22)) break; }
        __builtin_amdgcn_fence(__ATOMIC_ACQUIRE, "agent");
        asm volatile("s_waitcnt vmcnt(0)" ::: "memory");
    }
    __syncthreads();
}
__device__ __forceinline__ void svc_gemm1(Ctx& X, int layer, int sw) {
    const bf16_t* Hs = (const bf16_t*)(X.ws + WS_H) + (size_t)MP * 1024;
    const bf16_t* Wt = (const bf16_t*)(X.ws + WS_WIN + layer * SZ_WIN1);
    bf16_t* Z = (bf16_t*)(X.ws + WS_Z); const float* rope = (const float*)(X.ws + WS_ROPE) + 2048 * 16;
    const int r32 = X.lane & 31, hi = X.lane >> 5;
    for (int cb = sw; cb < ZN / 32; cb += NSVC * 8) {
        const f32x16 acc = skinny_block<1024>(Hs, 1024, Wt + (size_t)cb * 32 * 1024, X.lane);
        const int n = cb * 32 + r32, hc = n & 63;
        const bool ropeblk = (cb * 32 < 1536) && (((cb * 32) & 63) == 0);
        const float cs = rope[hc & 7], sn = rope[8 + (hc & 7)], sgn = (hc < 8) ? -1.f : 1.f;
        const float qs = (n < 768) ? QSCALE : 1.f;
        float* st = nullptr; int Wg = 0;
        if (n >= 768 && n < 2304) { const bool isv = n >= 1536; const int nn = n - (isv ? 1536 : 768); const int g = nn >> 8; Wg = 128 << (2 * g);
            const size_t base = isv ? (g == 0 ? O_SV0 : g == 1 ? O_SV1 : O_SV2) : (g == 0 ? O_SK0 : g == 1 ? O_SK1 : O_SK2); st = X.out + base + (size_t)(Wg - 1) * 256 + (nn & 255); }
#pragma unroll
        for (int r = 0; r < 16; ++r) { const int m = crow(r, hi); float v = acc[r];
            if (ropeblk) { const float p = __shfl_xor(v, 8); if (hc < 16) v = v * cs + sgn * p * sn; }
            v *= qs;
            st_wt16(Z + ((size_t)MP + m) * ZN + n, (bf16_t)(cvt_pk_bf16(v, 0.f) & 0xffffu));
            if (st) st[(size_t)(layer * 32 + m) * Wg * 256] = v; }
    }
}
template <int K, int KS>
__device__ __forceinline__ void skinny_part2(const bf16_t* A, int lda, const bf16_t* Bt0, const bf16_t* Bt1, int wave, int lane, f32x16& acc0, f32x16& acc1) {
    const int r32 = lane & 31, hi = lane >> 5;
    const bf16_t* ap = A + (size_t)r32 * lda + wave * KS + hi * 8; const bf16_t* bp0 = Bt0 + (size_t)r32 * K + wave * KS + hi * 8; const bf16_t* bp1 = Bt1 + (size_t)r32 * K + wave * KS + hi * 8;
    bf16x8 a[KS / 16], b0[KS / 16], b1[KS / 16];
#pragma unroll
    for (int j = 0; j < KS / 16; ++j) { a[j] = *(const bf16x8*)(ap + 16 * j); b0[j] = *(const bf16x8*)(bp0 + 16 * j); b1[j] = *(const bf16x8*)(bp1 + 16 * j); }
    __builtin_amdgcn_sched_barrier(0);
#pragma unroll
    for (int j = 0; j < KS / 16; ++j) { acc0 = __builtin_amdgcn_mfma_f32_32x32x16_bf16(a[j], b0[j], acc0, 0, 0, 0); acc1 = __builtin_amdgcn_mfma_f32_32x32x16_bf16(a[j], b1[j], acc1, 0, 0, 0); }
}
__device__ __forceinline__ void svc_gemm2(Ctx& X, int layer, int sv) {
    const bf16_t* Z = (const bf16_t*)(X.ws + WS_Z); bf16_t* MG = (bf16_t*)(X.ws + WS_MG);
    const int r32 = X.lane & 31, hi = X.lane >> 5;
    LAS float* red = (LAS float*)X.lds;
    const int cb0 = sv, cb1 = (sv + NSVC < 32) ? sv + NSVC : sv;
    const bf16_t* Wao = (const bf16_t*)(X.ws + WS_WAO + layer * SZ_WAO1); const bf16_t* Wco = (const bf16_t*)(X.ws + WS_WCO + layer * SZ_WAO1);
    f32x16 ya0 = {}, ya1 = {}, yc0 = {}, yc1 = {};
    bf16_t gma[2][2], gmc[2][2];
#pragma unroll
    for (int q = 0; q < 2; ++q) { const size_t m = (size_t)MP + crow(2 * X.wave + q, hi);
        gma[q][0] = Z[m * ZN + ZC_MA + cb0 * 32 + r32]; gmc[q][0] = Z[m * ZN + ZC_MC + cb0 * 32 + r32]; gma[q][1] = Z[m * ZN + ZC_MA + cb1 * 32 + r32]; gmc[q][1] = Z[m * ZN + ZC_MC + cb1 * 32 + r32]; }
    skinny_part2<768, 96>((const bf16_t*)(X.ws + WS_A2) + (size_t)MP * 768, 768, Wao + (size_t)cb0 * 32 * 768, Wao + (size_t)cb1 * 32 * 768, X.wave, X.lane, ya0, ya1);
    skinny_part2<768, 96>((const bf16_t*)(X.ws + WS_C2) + (size_t)MP * 768, 768, Wco + (size_t)cb0 * 32 * 768, Wco + (size_t)cb1 * 32 * 768, X.wave, X.lane, yc0, yc1);
#pragma unroll
    for (int r = 0; r < 16; ++r) { red[((0 * 8 + X.wave) * 16 + r) * 64 + X.lane] = ya0[r]; red[((1 * 8 + X.wave) * 16 + r) * 64 + X.lane] = yc0[r];
                                   red[((2 * 8 + X.wave) * 16 + r) * 64 + X.lane] = ya1[r]; red[((3 * 8 + X.wave) * 16 + r) * 64 + X.lane] = yc1[r]; }
    __syncthreads();
#pragma unroll
    for (int q = 0; q < 2; ++q) { const int r = 2 * X.wave + q; float sa0 = 0.f, sc0 = 0.f, sa1 = 0.f, sc1 = 0.f;
#pragma unroll
        for (int w = 0; w < 8; ++w) { sa0 += red[((0 * 8 + w) * 16 + r) * 64 + X.lane]; sc0 += red[((1 * 8 + w) * 16 + r) * 64 + X.lane]; sa1 += red[((2 * 8 + w) * 16 + r) * 64 + X.lane]; sc1 += red[((3 * 8 + w) * 16 + r) * 64 + X.lane]; }
        const size_t m = (size_t)MP + crow(r, hi);
        const float v0 = sigmoidf_(bf1(gma[q][0])) * sa0 + sigmoidf_(bf1(gmc[q][0])) * sc0, v1 = sigmoidf_(bf1(gma[q][1])) * sa1 + sigmoidf_(bf1(gmc[q][1])) * sc1;
        st_wt16(MG + m * 1024 + cb0 * 32 + r32, (bf16_t)(cvt_pk_bf16(v0, 0.f) & 0xffffu));
        if (cb1 != cb0) st_wt16(MG + m * 1024 + cb1 * 32 + r32, (bf16_t)(cvt_pk_bf16(v1, 0.f) & 0xffffu)); }
    __syncthreads();
}
__device__ __forceinline__ void svc_gemm3(Ctx& X, int layer, int sv) {
    float* R = (float*)(X.ws + WS_R);
    const int r32 = X.lane & 31, hi = X.lane >> 5;
    LAS float* red = (LAS float*)X.lds;
    const int cb0 = sv, cb1 = (sv + NSVC < 32) ? sv + NSVC : sv;
    const bf16_t* Wo = (const bf16_t*)(X.ws + WS_WO + layer * SZ_WO1);
    f32x16 r0 = {}, r1 = {};
    skinny_part2<1024, 128>((const bf16_t*)(X.ws + WS_MG) + (size_t)MP * 1024, 1024, Wo + (size_t)cb0 * 32 * 1024, Wo + (size_t)cb1 * 32 * 1024, X.wave, X.lane, r0, r1);
#pragma unroll
    for (int r = 0; r < 16; ++r) { red[((0 * 8 + X.wave) * 16 + r) * 64 + X.lane] = r0[r]; red[((1 * 8 + X.wave) * 16 + r) * 64 + X.lane] = r1[r]; }
    __syncthreads();
#pragma unroll
    for (int q = 0; q < 2; ++q) { const int r = 2 * X.wave + q; float s0 = 0.f, s1 = 0.f;
#pragma unroll
        for (int w = 0; w < 8; ++w) { s0 += red[((0 * 8 + w) * 16 + r) * 64 + X.lane]; s1 += red[((1 * 8 + w) * 16 + r) * 64 + X.lane]; }
        st_wt32(R + ((size_t)MP + crow(r, hi)) * 1024 + cb0 * 32 + r32, s0);
        if (cb1 != cb0) st_wt32(R + ((size_t)MP + crow(r, hi)) * 1024 + cb1 * 32 + r32, s1); }
    __syncthreads();
}
__device__ __forceinline__ void service_layer(Ctx& X, int layer) {
    const int sv = X.vb - NG1, sw = sv * 8 + X.wave;
    const unsigned e0 = (unsigned)layer * 5u * NSVC;
    const bf16_t* Z = (const bf16_t*)(X.ws + WS_Z); bf16_t* A2 = (bf16_t*)(X.ws + WS_A2); bf16_t* C2 = (bf16_t*)(X.ws + WS_C2);
    svc_gemm1(X, layer, sw);
    svc_barrier(X, e0 + 1u * NSVC);
    if (sw < 128) attn_sample_unit3(Z, X.in, A2, layer, sw, X.lds + X.wave * 12288, X.lane);
    __syncthreads();
    conv_sample_pair(X, Z, C2, layer, sv);
    svc_barrier(X, e0 + 2u * NSVC);
    svc_gemm2(X, layer, sv);
    svc_barrier(X, e0 + 3u * NSVC);
    svc_gemm3(X, layer, sv);
    svc_barrier(X, e0 + 4u * NSVC);
    if (sw < DEC_BATCH) p5_row<true>(X, layer, MP + sw);
    svc_barrier(X, e0 + 5u * NSVC);
}

constexpr int N_PHASES = 1 + 4 * DEPTH;
__global__ void __launch_bounds__(NWAVES * 64, 2) hybrid_fwd(Args args) {
    extern __shared__ __attribute__((aligned(16))) unsigned char lds_raw[];
    Ctx X;
    X.lds = (LAS unsigned char*)lds_raw;
    X.tid = threadIdx.x; X.lane = X.tid & 63; X.wave = __builtin_amdgcn_readfirstlane(X.tid >> 6);
    X.G = gridDim.x;
    X.in = args.in; X.out = args.out; X.ws = args.ws;
    volatile LAS unsigned* MISC = (volatile LAS unsigned*)(X.lds + MISC_OFF);
    for (int u = X.tid; u < (LDS_BYTES - LDSCTL_OFF) / 4; u += NWAVES * 64) ((LAS unsigned*)(X.lds + LDSCTL_OFF))[u] = 0u;
    __syncthreads();
    {
        const unsigned x = xb_xcc_id() & 7u;
        if (X.tid == 0) MISC[16] = xb_add((unsigned*)(X.ws + WS_CTL) + CW_RANK + 64 * x, 1u) & 31u;
        __syncthreads();
        X.xcc = (int)x; X.rank = __builtin_amdgcn_readfirstlane((int)MISC[16]); X.vb = X.rank * 8 + X.xcc; X.vcu = X.xcc * 32 + X.rank;
    }
    const int xcc0 = X.xcc, rank0 = X.rank;
    unsigned* barw = (unsigned*)(X.ws + WS_CTL) + CW_BAR;
    XcdBarrier bar; bar.bar = barw; bar.x = 0; bar.st = nullptr;
    bar = xcd_barrier_post(barw, MISC + 8);
    const int wave0 = X.wave;

    unsigned nxl = 0;
    for (int ph = 0; ph < N_PHASES; ++ph) {
        { GAS unsigned char* w_ = (GAS unsigned char*)args.ws; GAS float* o_ = (GAS float*)args.out; asm volatile("" : "+s"(w_), "+s"(o_)); X.ws = (unsigned char*)w_; X.out = (float*)o_;
          int wv_ = wave0, ln_; asm volatile("" : "+s"(wv_)); asm volatile("v_mbcnt_lo_u32_b32 %0, -1, 0\n\tv_mbcnt_hi_u32_b32 %0, -1, %0" : "=v"(ln_));
          X.tid = wv_ * 64 + ln_; X.lane = ln_; X.wave = wv_;
          int x_ = xcc0, r_ = rank0; asm volatile("" : "+s"(x_), "+s"(r_)); X.xcc = x_; X.rank = r_; X.vb = r_ * 8 + x_; X.vcu = x_ * 32 + r_; }
        if (ph == 0) { p0_prep(X); }
        else {
            const int layer = (ph - 1) / 4, sub = (ph - 1) % 4;
            if (sub == 0) {
                if (X.vb < NG1) {
                    pg8::Sched S; S.init(MP, ZN, 1024, NG1, X.vb, 1, X.ws + WS_H, X.ws + WS_WIN + layer * SZ_WIN1, nullptr, nullptr); S.wgm = 4; S.rev = true;
                    Epi1 E{(bf16_t*)(X.ws + WS_Z), (const float*)(X.ws + WS_ROPE), X.out, layer, X.in, layer * 2, X.vb};
                    pg8::gemm_phase<Epi1, true>(X.lds, 1024, S, E, X.tid);
                } else {
                    service_layer(X, layer);
                }
            } else if (sub == 1) {
                p2_mix(X, layer);
            } else if (sub == 2) {
                pg8::Sched S; S.init(MP, 1024, 768, X.G, X.vb, 2, X.ws + WS_C2, X.ws + WS_WCO + layer * SZ_WAO1, X.ws + WS_A2, X.ws + WS_WAO + layer * SZ_WAO1);
                Epi2 E{(const bf16_t*)(X.ws + WS_Z), (bf16_t*)(X.ws + WS_MG), (unsigned*)(X.ws + WS_CTL) + CW_XC + 64 * X.xcc, (unsigned*)(X.ws + WS_CTL) + CW_XP + 64 * X.xcc, 32u * (unsigned)(layer + 1)};
                pg8::gemm_phase<Epi2, true>(X.lds, 768, S, E, X.tid);
                if (X.tid == 0) xb_add((unsigned*)(X.ws + WS_CTL) + CW_PAN1 + 64 * (8 * X.xcc + (X.rank & 7)), 1u);
            } else if (sub == 3) {
                pg8::Sched S; S.init(MP, 1024, 1024, X.G, X.vb, 1, X.ws + WS_MG, X.ws + WS_WO + layer * SZ_WO1, nullptr, nullptr);
                Epi3F<false> E{X.in[0], X.out, (bf16_t*)(X.ws + WS_H), X.in[17] + (size_t)layer * 1024, X.in[16] + (size_t)(layer + 1 < DEPTH ? layer + 1 : 0) * 1024,
                    (float*)(X.ws + WS_XB1), (float*)(X.ws + WS_XB2), (unsigned*)(X.ws + WS_CTL) + CW_PAN1, (unsigned*)(X.ws + WS_CTL) + CW_PAN2, 4u * (unsigned)(layer + 1), layer + 1 == DEPTH, X.in[16] + (size_t)layer * 1024, (float*)(X.ws + WS_RS)};
                pg8::gemm_phase<Epi3F<false>, false>(X.lds, 1024, S, E, X.tid);
            }
        }
        if (ph + 1 < N_PHASES) {
            if (ph == 0) xcd_barrier(bar);
            else if ((ph - 1) % 4 == 0 || (ph - 1) % 4 == 3) {
                ++nxl; unsigned* xl = (unsigned*)(X.ws + WS_CTL) + CW_XL + 64 * X.xcc;
                xl_arrive(xl);
                { const int bslot = 2 * ((ph - 1) / 4) + ((ph - 1) % 4 == 3 ? 1 : 0);
                  _Pragma("unroll 1") for (int k = 0; k < NBPW; ++k) { const int pid = ((bslot * NBPW + k) * 256 + X.vb) * 8 + X.wave;
                      const Piece CP = piece_of(X.in, X.out, pid, X.lane); f32x4 cpr[16]; PC_LOAD(cpr, CP, 0, 16) PC_STORE(cpr, CP, 0, 16) } }
                xl_wait(xl, 32u * nxl);
            }
        }
    }
}

extern "C" void kernel_launch(void* const* d_in, const int* in_sizes, int n_in, void* d_out, int out_size, void* d_ws, size_t ws_size, hipStream_t stream) {
    static int grid = 0;
    if (grid == 0) {
        if (n_in != 18 || (size_t)out_size != O_END || ws_size < WS_END) { fprintf(stderr, "kernel_launch: unexpected shapes: n_in %d out %d ws %zu (need %zu)\n", n_in, out_size, ws_size, (size_t)WS_END); grid = -1; return; }
        int dev = 0, cus = 0;
        if (hipGetDevice(&dev) != hipSuccess || hipDeviceGetAttribute(&cus, hipDeviceAttributeMultiprocessorCount, dev) != hipSuccess) { grid = -1; return; }
        if (hipFuncSetAttribute((const void*)hybrid_fwd, hipFuncAttributeMaxDynamicSharedMemorySize, LDS_BYTES) != hipSuccess) { fprintf(stderr, "kernel_launch: hipFuncSetAttribute failed\n"); grid = -1; return; }
        int per_cu = 0;
        if (hipOccupancyMaxActiveBlocksPerMultiprocessor(&per_cu, (const void*)hybrid_fwd, NWAVES * 64, LDS_BYTES) != hipSuccess || per_cu < 1) fprintf(stderr, "kernel_launch: occupancy query reports %d\n", per_cu);
        (void)hipGetLastError();
        grid = cus;
        if (grid != NG1 + NSVC) { fprintf(stderr, "kernel_launch: built for %d CUs, device has %d\n", NG1 + NSVC, cus); grid = -1; return; }
    }
    if (grid < 0) return;
    (void)hipMemsetAsync((char*)d_ws + WS_CTL, 0, CTL_ZERO_BYTES, stream);
    Args a{};
    for (int i = 0; i < 18; ++i) a.in[i] = (const float*)d_in[i];
    a.out = (float*)d_out; a.ws = (unsigned char*)d_ws;
    a.ph_lo = 0; a.ph_hi = N_PHASES; a.li = 0;
    hipLaunchKernelGGL(hybrid_fwd, dim3(grid), dim3(NWAVES * 64), LDS_BYTES, stream, a);
}
```
